# Optimizing an MI355X kernel written in HIP

```python
import math
import jax
import jax.numpy as jnp
from jax import lax
import numpy as np

D_MODEL = 1024
BATCH = 4
SEQ = 8192
DEPTH = 1

GRID_W = 64
CTX_LEN = 256
S5_WIDTH = 512
S5_GROUP_CH = 16
S5_GROUPS = S5_WIDTH // S5_GROUP_CH
S5_STATE = 64
DT_MIN = 1e-3
DT_MAX = 1e-1
CONV_WIDTH = 512
CONV_K = 3
N_EXPERT_GROUPS = 4
EXPERTS_PER_GROUP = 8
N_EXPERTS = N_EXPERT_GROUPS * EXPERTS_PER_GROUP
EXPERT_FF = 512
TOP_K_IN_GROUP = 2
EXPERT_BLOCK = 128
IN_PROJ_WIDTH = S5_WIDTH + 3 * CONV_WIDTH + 2 * D_MODEL
ALPHA = (2.0 * DEPTH) ** 0.25
BETA = (8.0 * DEPTH) ** -0.25
LN_EPS = 1e-6
POS_BASE = 10000.0

kernel_name = 'hybrid_s5_shortconv_hmoe_prefix_block'


def _layer_norm(x, gain=None, bias=None):
    xf = x.astype(jnp.float32)
    mu = xf.mean(-1, keepdims=True)
    var = jnp.square(xf - mu).mean(-1, keepdims=True)
    y = (xf - mu) * lax.rsqrt(var + LN_EPS)
    if gain is not None:
        y = y * gain.astype(jnp.float32) + bias.astype(jnp.float32)
    return y.astype(x.dtype)


def _modulate(xn, shift, scale):
    return xn * (1.0 + scale) + shift


def _sincos_2d(rows, cols, dim):
    q = dim // 4
    omega = 1.0 / (POS_BASE ** (jnp.arange(q, dtype=jnp.float32) / q))
    r = jnp.arange(rows, dtype=jnp.float32)[:, None] * omega
    cl = jnp.arange(cols, dtype=jnp.float32)[:, None] * omega
    r_emb = jnp.concatenate([jnp.sin(r), jnp.cos(r)], -1)
    c_emb = jnp.concatenate([jnp.sin(cl), jnp.cos(cl)], -1)
    emb = jnp.concatenate([jnp.broadcast_to(r_emb[:, None, :], (rows, cols, 2 * q)),
                           jnp.broadcast_to(c_emb[None, :, :], (rows, cols, 2 * q))], -1)
    return emb.reshape(rows * cols, dim)


def _ssm_combine(e1, e2):
    a1r, a1i, b1r, b1i = e1
    a2r, a2i, b2r, b2i = e2
    return (a1r * a2r - a1i * a2i, a1r * a2i + a1i * a2r,
            a2r * b1r - a2i * b1i + b2r, a2r * b1i + a2i * b1r + b2i)


def _s5_groups(u):
    b, l, _ = u.shape
    return u.reshape(b, l, S5_GROUPS, S5_GROUP_CH).astype(jnp.float32)


def _s5_dir(lp, d):
    return (lp['s5_log_dt_' + d], lp['s5_a_re_' + d], lp['s5_a_im_' + d],
            lp['s5_b_re_' + d], lp['s5_b_im_' + d])


def _s5_states(ug, log_dt, a_re, a_im, b_re, b_im, s0, reverse):
    f32 = jnp.float32
    dt = jnp.exp(log_dt.astype(f32))[:, None]
    a_re = a_re.astype(f32)
    a_im = a_im.astype(f32)
    mag = jnp.exp(dt * a_re)
    ab_re = mag * jnp.cos(dt * a_im)
    ab_im = mag * jnp.sin(dt * a_im)
    den = a_re * a_re + a_im * a_im
    x_re = ab_re - 1.0
    f_re = (x_re * a_re + ab_im * a_im) / den
    f_im = (ab_im * a_re - x_re * a_im) / den
    b_re = b_re.astype(f32)
    b_im = b_im.astype(f32)
    bb_re = f_re[..., None] * b_re - f_im[..., None] * b_im
    bb_im = f_re[..., None] * b_im + f_im[..., None] * b_re
    bu_re = jnp.einsum('blgc,gnc->blgn', ug, bb_re)
    bu_im = jnp.einsum('blgc,gnc->blgn', ug, bb_im)
    if s0 is not None:
        s0_re, s0_im = s0
        edge = -1 if reverse else 0
        bu_re = bu_re.at[:, edge].add(ab_re * s0_re - ab_im * s0_im)
        bu_im = bu_im.at[:, edge].add(ab_re * s0_im + ab_im * s0_re)
    l = ug.shape[1]
    a_seq_re = jnp.broadcast_to(ab_re, (1, l) + ab_re.shape)
    a_seq_im = jnp.broadcast_to(ab_im, (1, l) + ab_im.shape)
    _, _, s_re, s_im = lax.associative_scan(_ssm_combine, (a_seq_re, a_seq_im, bu_re, bu_im),
                                            reverse=reverse, axis=1)
    return s_re, s_im


def _edge_state(s_re, s_im, reverse):
    e = 0 if reverse else -1
    return (s_re[:, e], s_im[:, e])


def _s5_readout(s_re, s_im, c_re, c_im):
    return (jnp.einsum('blgn,gcn->blgc', s_re, c_re.astype(jnp.float32))
            - jnp.einsum('blgn,gcn->blgc', s_im, c_im.astype(jnp.float32)))


def _short_conv(v, w, row_w):
    b, l, ch = v.shape
    seg = l if row_w is None else row_w
    vr = v.reshape(b * (l // seg), seg, ch)
    vp = jnp.pad(vr, ((0, 0), (1, 1), (0, 0)))
    out = w[0] * vp[:, :-2] + w[1] * vp[:, 1:-1] + w[2] * vp[:, 2:]
    return out.reshape(b, l, ch)


def _token_mixer(h, lp, row_w, s0_f, s0_b):
    b, l, _ = h.shape
    proj = h @ lp['w_in']
    o1 = S5_WIDTH
    o2 = o1 + CONV_WIDTH
    o3 = o2 + CONV_WIDTH
    o4 = o3 + CONV_WIDTH
    o5 = o4 + D_MODEL
    u_a, z_b, gate_b, gate_c = proj[..., :o1], proj[..., o1:o2], proj[..., o2:o3], proj[..., o3:o4]
    merge_a, merge_b = proj[..., o4:o5], proj[..., o5:]
    ug = _s5_groups(u_a)
    sf_re, sf_im = _s5_states(ug, *_s5_dir(lp, 'f'), s0_f, False)
    y_a = _s5_readout(sf_re, sf_im, lp['s5_c_re_f'], lp['s5_c_im_f'])
    fin_f = _edge_state(sf_re, sf_im, False)
    sb_re, sb_im = _s5_states(ug, *_s5_dir(lp, 'b'), s0_b, True)
    y_a = y_a + _s5_readout(sb_re, sb_im, lp['s5_c_re_b'], lp['s5_c_im_b'])
    fin_b = _edge_state(sb_re, sb_im, True)
    y_a = (y_a + lp['s5_d'].astype(jnp.float32) * ug).reshape(b, l, S5_WIDTH).astype(h.dtype)
    ya = jax.nn.gelu(y_a)
    out_a = (ya @ lp['s5_w_glu_val']) * jax.nn.sigmoid(ya @ lp['s5_w_glu_gate'])
    v = _short_conv(gate_c * z_b, lp['conv_w'], row_w)
    out_b = (gate_b * v) @ lp['conv_w_out']
    merged = jax.nn.sigmoid(merge_a) * out_a + jax.nn.sigmoid(merge_b) * out_b
    return merged @ lp['w_o'], fin_f, fin_b


def _routed_experts(hf, e_idx, w_gate, w_up, w_down):
    t, k = e_idx.shape
    d = hf.shape[-1]
    n_exp = w_gate.shape[0]
    n_assign = t * k
    flat_e = e_idx.reshape(n_assign)
    order = jnp.argsort(flat_e)
    sorted_e = flat_e[order]
    counts = jnp.zeros((n_exp,), jnp.int32).at[flat_e].add(1)
    padded = (counts + EXPERT_BLOCK - 1) // EXPERT_BLOCK * EXPERT_BLOCK
    pad_end = jnp.cumsum(padded)
    pad_start = pad_end - padded
    start = jnp.cumsum(counts) - counts
    dest = pad_start[sorted_e] + jnp.arange(n_assign, dtype=jnp.int32) - start[sorted_e]
    n_blocks = (n_assign + EXPERT_BLOCK - 1) // EXPERT_BLOCK + n_exp
    n_rows = n_blocks * EXPERT_BLOCK
    src_tok = jnp.full((n_rows,), t, jnp.int32).at[dest].set(order // k)
    h_pad = jnp.concatenate([hf, jnp.zeros((1, d), hf.dtype)], 0)
    xb = h_pad[src_tok].reshape(n_blocks, EXPERT_BLOCK, d)
    block_e = jnp.minimum(jnp.searchsorted(pad_end, jnp.arange(n_blocks, dtype=jnp.int32) * EXPERT_BLOCK,
                                           side='right'), n_exp - 1)

    def _expert_block(args):
        xblk, e = args
        hid = jax.nn.silu(xblk @ w_gate[e]) * (xblk @ w_up[e])
        return hid @ w_down[e]

    yb = lax.map(_expert_block, (xb, block_e)).reshape(n_rows, d)
    dest_of_assign = jnp.zeros((n_assign,), jnp.int32).at[order].set(dest)
    return yb[dest_of_assign].reshape(t, k, d)


def _hier_moe(h, lp):
    b, l, d = h.shape
    f32 = jnp.float32
    hf = h.reshape(b * l, d)
    g_logits = (hf @ lp['router_w_group']).astype(f32) + lp['router_b_group'].astype(f32)
    g_prob = jax.nn.softmax(g_logits, axis=-1)
    g_idx = jnp.argmax(g_logits, axis=-1).astype(jnp.int32)
    p_group = jnp.take_along_axis(g_prob, g_idx[:, None], axis=-1)
    e_logits = ((hf @ lp['router_w_expert']).astype(f32) + lp['router_b_expert'].astype(f32)
                ).reshape(-1, N_EXPERT_GROUPS, EXPERTS_PER_GROUP)
    e_sel = jnp.take_along_axis(e_logits, g_idx[:, None, None], axis=1)[:, 0]
    e_prob = jax.nn.softmax(e_sel, axis=-1)
    top_p, top_i = lax.top_k(e_prob, TOP_K_IN_GROUP)
    weights = p_group * top_p / top_p.sum(-1, keepdims=True)
    e_idx = g_idx[:, None] * EXPERTS_PER_GROUP + top_i.astype(jnp.int32)
    y = _routed_experts(hf, e_idx, lp['exp_w_gate'], lp['exp_w_up'], lp['exp_w_down'])
    out = jnp.einsum('tkd,tk->td', y.astype(f32), weights)
    return out.astype(h.dtype).reshape(b, l, d)


def setup_inputs(seed: int = 0) -> dict:
    key = jax.random.key(seed)
    ks = iter(jax.random.split(key, 48))
    f32 = jnp.float32

    def nrm(shape, scale):
        return jax.random.normal(next(ks), shape, f32) * scale

    def s5_dir():
        log_dt = jax.random.uniform(next(ks), (DEPTH, S5_GROUPS), f32, math.log(DT_MIN), math.log(DT_MAX))
        a_re = -0.5 + nrm((DEPTH, S5_GROUPS, S5_STATE), 0.01)
        a_im = math.pi * jnp.arange(S5_STATE, dtype=f32) + nrm((DEPTH, S5_GROUPS, S5_STATE), 0.01)
        b_re = nrm((DEPTH, S5_GROUPS, S5_STATE, S5_GROUP_CH), (2 * S5_GROUP_CH) ** -0.5)
        b_im = nrm((DEPTH, S5_GROUPS, S5_STATE, S5_GROUP_CH), (2 * S5_GROUP_CH) ** -0.5)
        c_re = nrm((DEPTH, S5_GROUPS, S5_GROUP_CH, S5_STATE), 0.5)
        c_im = nrm((DEPTH, S5_GROUPS, S5_GROUP_CH, S5_STATE), 0.5)
        return log_dt, a_re, a_im, b_re, b_im, c_re, c_im

    x = nrm((BATCH, SEQ, D_MODEL), 1.0)
    c = nrm((BATCH, D_MODEL), 1.0)
    ctx = nrm((BATCH, CTX_LEN, D_MODEL), 1.0)
    c_ctx = nrm((D_MODEL,), 1.0)
    w_ada = nrm((DEPTH, D_MODEL, 6 * D_MODEL), 0.5 * D_MODEL ** -0.5)
    b_ada = nrm((DEPTH, 6 * D_MODEL), 0.02)
    w_in = nrm((DEPTH, D_MODEL, IN_PROJ_WIDTH), D_MODEL ** -0.5)
    f_par = s5_dir()
    b_par = s5_dir()
    s5_d = nrm((DEPTH, S5_GROUPS, S5_GROUP_CH), 1.0)
    s5_w_glu_val = nrm((DEPTH, S5_WIDTH, D_MODEL), BETA * S5_WIDTH ** -0.5)
    s5_w_glu_gate = nrm((DEPTH, S5_WIDTH, D_MODEL), S5_WIDTH ** -0.5)
    conv_w = nrm((DEPTH, CONV_K, CONV_WIDTH), CONV_K ** -0.5)
    conv_w_out = nrm((DEPTH, CONV_WIDTH, D_MODEL), BETA * CONV_WIDTH ** -0.5)
    w_o = nrm((DEPTH, D_MODEL, D_MODEL), BETA * D_MODEL ** -0.5)
    ln1_g = 1.0 + nrm((DEPTH, D_MODEL), 0.02)
    ln1_b = nrm((DEPTH, D_MODEL), 0.02)
    router_w_group = nrm((DEPTH, D_MODEL, N_EXPERT_GROUPS), D_MODEL ** -0.5)
    router_b_group = nrm((DEPTH, N_EXPERT_GROUPS), 0.01)
    router_w_expert = nrm((DEPTH, D_MODEL, N_EXPERTS), D_MODEL ** -0.5)
    router_b_expert = nrm((DEPTH, N_EXPERTS), 0.01)
    exp_w_gate = nrm((DEPTH, N_EXPERTS, D_MODEL, EXPERT_FF), D_MODEL ** -0.5)
    exp_w_up = nrm((DEPTH, N_EXPERTS, D_MODEL, EXPERT_FF), D_MODEL ** -0.5)
    exp_w_down = nrm((DEPTH, N_EXPERTS, EXPERT_FF, D_MODEL), BETA * EXPERT_FF ** -0.5)
    ln2_g = 1.0 + nrm((DEPTH, D_MODEL), 0.02)
    ln2_b = nrm((DEPTH, D_MODEL), 0.02)
    return {
        'x': x, 'c': c, 'ctx': ctx, 'c_ctx': c_ctx,
        'w_ada': w_ada, 'b_ada': b_ada, 'w_in': w_in,
        's5_log_dt_f': f_par[0], 's5_a_re_f': f_par[1], 's5_a_im_f': f_par[2],
        's5_b_re_f': f_par[3], 's5_b_im_f': f_par[4], 's5_c_re_f': f_par[5], 's5_c_im_f': f_par[6],
        's5_log_dt_b': b_par[0], 's5_a_re_b': b_par[1], 's5_a_im_b': b_par[2],
        's5_b_re_b': b_par[3], 's5_b_im_b': b_par[4], 's5_c_re_b': b_par[5], 's5_c_im_b': b_par[6],
        's5_d': s5_d, 's5_w_glu_val': s5_w_glu_val, 's5_w_glu_gate': s5_w_glu_gate,
        'conv_w': conv_w, 'conv_w_out': conv_w_out, 'w_o': w_o,
        'ln1_g': ln1_g, 'ln1_b': ln1_b,
        'router_w_group': router_w_group, 'router_b_group': router_b_group,
        'router_w_expert': router_w_expert, 'router_b_expert': router_b_expert,
        'exp_w_gate': exp_w_gate, 'exp_w_up': exp_w_up, 'exp_w_down': exp_w_down,
        'ln2_g': ln2_g, 'ln2_b': ln2_b,
    }


def reference(x, c, ctx, c_ctx, w_ada, b_ada, w_in,
              s5_log_dt_f, s5_a_re_f, s5_a_im_f, s5_b_re_f, s5_b_im_f, s5_c_re_f, s5_c_im_f,
              s5_log_dt_b, s5_a_re_b, s5_a_im_b, s5_b_re_b, s5_b_im_b, s5_c_re_b, s5_c_im_b,
              s5_d, s5_w_glu_val, s5_w_glu_gate, conv_w, conv_w_out, w_o, ln1_g, ln1_b,
              router_w_group, router_b_group, router_w_expert, router_b_expert,
              exp_w_gate, exp_w_up, exp_w_down, ln2_g, ln2_b):
    stacked = dict(
        w_ada=w_ada, b_ada=b_ada, w_in=w_in,
        s5_log_dt_f=s5_log_dt_f, s5_a_re_f=s5_a_re_f, s5_a_im_f=s5_a_im_f, s5_b_re_f=s5_b_re_f,
        s5_b_im_f=s5_b_im_f, s5_c_re_f=s5_c_re_f, s5_c_im_f=s5_c_im_f,
        s5_log_dt_b=s5_log_dt_b, s5_a_re_b=s5_a_re_b, s5_a_im_b=s5_a_im_b, s5_b_re_b=s5_b_re_b,
        s5_b_im_b=s5_b_im_b, s5_c_re_b=s5_c_re_b, s5_c_im_b=s5_c_im_b,
        s5_d=s5_d, s5_w_glu_val=s5_w_glu_val, s5_w_glu_gate=s5_w_glu_gate,
        conv_w=conv_w, conv_w_out=conv_w_out, w_o=w_o, ln1_g=ln1_g, ln1_b=ln1_b,
        router_w_group=router_w_group, router_b_group=router_b_group,
        router_w_expert=router_w_expert, router_b_expert=router_b_expert,
        exp_w_gate=exp_w_gate, exp_w_up=exp_w_up, exp_w_down=exp_w_down,
        ln2_g=ln2_g, ln2_b=ln2_b)
    rows = x.shape[1] // GRID_W
    x = x + _sincos_2d(rows, GRID_W, x.shape[-1]).astype(x.dtype)
    for layer in range(DEPTH):
        lp = {name: arr[layer] for name, arr in stacked.items()}
        mod_lat = jax.nn.silu(c) @ lp['w_ada'] + lp['b_ada']
        mod_ctx = jax.nn.silu(c_ctx) @ lp['w_ada'] + lp['b_ada']
        sh1, sc1, g1, sh2, sc2, g2 = jnp.split(mod_lat[:, None, :], 6, axis=-1)
        csh1, csc1, cg1, csh2, csc2, cg2 = jnp.split(mod_ctx, 6, axis=-1)
        h_ctx = _modulate(_layer_norm(ctx), csh1, csc1)
        if layer == DEPTH - 1:
            ug_ctx = _s5_groups(h_ctx @ lp['w_in'][:, :S5_WIDTH])
            s0_f = _edge_state(*_s5_states(ug_ctx, *_s5_dir(lp, 'f'), None, False), False)
            s0_b = _edge_state(*_s5_states(ug_ctx, *_s5_dir(lp, 'b'), None, True), True)
        else:
            mix_ctx, s0_f, s0_b = _token_mixer(h_ctx, lp, None, None, None)
            ctx = _layer_norm(ALPHA * ctx + cg1 * mix_ctx, lp['ln1_g'], lp['ln1_b'])
            h2_ctx = _modulate(_layer_norm(ctx), csh2, csc2)
            ctx = _layer_norm(ALPHA * ctx + cg2 * _hier_moe(h2_ctx, lp), lp['ln2_g'], lp['ln2_b'])
        h = _modulate(_layer_norm(x), sh1, sc1)
        mix, _, _ = _token_mixer(h, lp, GRID_W, s0_f, s0_b)
        x = _layer_norm(ALPHA * x + g1 * mix, lp['ln1_g'], lp['ln1_b'])
        h2 = _modulate(_layer_norm(x), sh2, sc2)
        x = _layer_norm(ALPHA * x + g2 * _hier_moe(h2, lp), lp['ln2_g'], lp['ln2_b'])
    return x
```

```cpp
#include <hip/hip_runtime.h>
#include <math.h>
#include <stdio.h>

#ifndef SIMPLE_RED
#define SIMPLE_RED 0
#endif
#ifndef DOT2_BUILTIN
#define DOT2_BUILTIN 1
#endif
#ifndef DUPMASK
#define DUPMASK 0
#endif
#ifndef NOEPI_DUP
#define NOEPI_DUP 0
#endif
#ifndef DUPEPI
#define DUPEPI 0
#endif
#ifndef SDUP
#define SDUP 0
#endif
#ifndef DUPBAR
#define DUPBAR 0
#endif
namespace {
typedef unsigned short bf16;
constexpr int D = 1024, NBATCH = 4, L = 8192, T = NBATCH * L, CTXL = 256, TC = NBATCH * CTXL, TALL = T + TC;
constexpr int NG = 32, NS = 64, NE = 32, FF = 512, INW = 4096;
constexpr int QC = 32;
constexpr int NCR = 1280;
constexpr int UGK = 768;
constexpr int NSLOT = 2 * T + NE * 256;
constexpr float ALPHA = 1.189207115002721f, LN_EPS = 1e-6f;

constexpr size_t MiB = 1u << 20;
constexpr size_t WS_CTL = 0;
constexpr size_t WS_MOD = 1 * MiB;
constexpr size_t WS_POS = 2 * MiB;
constexpr size_t WS_ROUT = 3 * MiB;
constexpr size_t RT_EIDX = 0, RT_WGT = 256 * 1024, RT_TOK = 512 * 1024, RT_ASG = 1024 * 1024, RT_CNT = 1536 * 1024;
constexpr size_t RT_HIST = 1600 * 1024, RT_RANK = 1664 * 1024, RT_META = 1920 * 1024;
constexpr size_t WS_LOGIT = 6 * MiB;
constexpr size_t WS_WIN = 14 * MiB, WS_WGLU = 22 * MiB, WS_WCV = 24 * MiB, WS_WO = 25 * MiB, WS_WR = 27 * MiB, WS_PM = 28 * MiB, WS_TM = 36 * MiB, WS_WGU = 60 * MiB, WS_WD = 124 * MiB;
constexpr size_t WS_RA = 156 * MiB;
constexpr size_t WS_RB = 222 * MiB;
constexpr size_t WS_RD = 294 * MiB;
constexpr size_t WS_END = 422 * MiB;

__device__ __forceinline__ float bf2f(bf16 h) { return __uint_as_float(((unsigned)h) << 16); }
__device__ __forceinline__ bf16 f2bf(float f) { unsigned u = __float_as_uint(f); u += 0x7fffu + ((u >> 16) & 1u); return (bf16)(u >> 16); }
__device__ __forceinline__ float sigmoidf_(float x) { return 1.f / (1.f + expf(-x)); }
__device__ __forceinline__ float siluf_(float x) { return x / (1.f + expf(-x)); }
__device__ __forceinline__ float geluf_(float x) { return 0.5f * x * (1.f + tanhf(0.7978845608028654f * (x + 0.044715f * x * x * x))); }
__device__ __forceinline__ float wave_sum(float v) {
#pragma unroll
    for (int o = 32; o >= 1; o >>= 1) v += __shfl_xor(v, o);
    return v;
}
__device__ __forceinline__ float pos_emb(int l, int d) {
    const int row = l >> 6, col = l & 63; const int q = d >> 8, i = d & 255;
    const float omega = 1.0f / powf(10000.0f, (float)i / 256.0f);
    const float p = (q < 2) ? (float)row : (float)col; const float a = p * omega;
    return (q & 1) ? cosf(a) : sinf(a);
}
__device__ __forceinline__ size_t ug_index(int r, int c) { return ((size_t)(c >> 4) * NCR + (r >> 5)) * UGK + (r & 31) * 16 + (c & 15); }

__global__ __launch_bounds__(256) void k_mod(const float* c, const float* c_ctx, const float* w_ada, const float* b_ada, float* mod) {
    __shared__ float sc[5][1024];
    for (int i = threadIdx.x; i < 5 * 1024; i += blockDim.x) { const int v = i >> 10, k = i & 1023; const float x = v < 4 ? c[v * 1024 + k] : c_ctx[k]; sc[v][k] = siluf_(x); }
    __syncthreads();
    const int col = blockIdx.x * blockDim.x + threadIdx.x;
    float acc[5] = {0, 0, 0, 0, 0};
    for (int k = 0; k < 1024; ++k) { const float w = w_ada[(size_t)k * 6144 + col];
#pragma unroll
        for (int v = 0; v < 5; ++v) acc[v] += sc[v][k] * w; }
    const float bb = b_ada[col];
#pragma unroll
    for (int v = 0; v < 5; ++v) mod[v * 6144 + col] = acc[v] + bb;
}

__global__ __launch_bounds__(256) void k_lnmod(const float* x, const float* ctx, const float* mod, bf16* XN) {
    const int r = blockIdx.x * 4 + (threadIdx.x >> 6), lane = threadIdx.x & 63;
    float v[16]; float s = 0.f; int mv;
    if (r < T) { const int l = r & (L - 1); mv = r / L;
#pragma unroll
        for (int i = 0; i < 16; ++i) { const int d = lane + 64 * i; v[i] = x[(size_t)r * D + d] + pos_emb(l, d); s += v[i]; } }
    else { mv = 4;
#pragma unroll
        for (int i = 0; i < 16; ++i) { const int d = lane + 64 * i; v[i] = ctx[(size_t)(r - T) * D + d]; s += v[i]; } }
    const float mu = wave_sum(s) * (1.f / D); float q = 0.f;
#pragma unroll
    for (int i = 0; i < 16; ++i) { v[i] -= mu; q += v[i] * v[i]; }
    const float rstd = rsqrtf(wave_sum(q) * (1.f / D) + LN_EPS);
    const float* sh = mod + mv * 6144; const float* sc = sh + 1024;
#pragma unroll
    for (int i = 0; i < 16; ++i) { const int d = lane + 64 * i; XN[(size_t)r * D + d] = f2bf(v[i] * rstd * (1.f + sc[d]) + sh[d]); }
}

struct Stream { const bf16* A; const int* ridx; const float* B0; const float* B1; size_t bstride; int lda; int K; int ldb; int pad; };
static Stream mk_stream(const bf16* A, int lda, const int* ridx, int K, const float* B0, const float* B1, int ldb, size_t bstride) {
    Stream s{}; s.A = A; s.ridx = ridx; s.B0 = B0; s.B1 = B1; s.bstride = bstride; s.lda = lda; s.K = K; s.ldb = ldb; s.pad = 0; return s; }
template <int NB>
__device__ __forceinline__ void gemm_accum(float (&acc)[NB][4][4], const Stream& s, size_t boff, int M, int rbase, int m0, int n0, float* As, float* Bs) {
    const int tid = threadIdx.x, tx = tid & 15, ty = tid >> 4;
    const int ar = tid >> 2, ak = (tid & 3) * 4, bk = tid >> 4, bn = (tid & 15) * 4;
    const int grow = m0 + ar; const bool av = grow < M;
    const size_t arow = av ? (s.ridx ? (size_t)s.ridx[rbase + grow] : (size_t)(rbase + grow)) : 0;
    const bf16* ap = s.A + arow * s.lda + ak;
    const float* Bp[2] = {s.B0 + boff, s.B1 ? s.B1 + boff : nullptr};
    for (int k0 = 0; k0 < s.K; k0 += 16) {
        const uint2 a = av ? *(const uint2*)(ap + k0) : make_uint2(0u, 0u);
        As[(ak + 0) * 68 + ar] = __uint_as_float(a.x << 16); As[(ak + 1) * 68 + ar] = __uint_as_float(a.x & 0xffff0000u);
        As[(ak + 2) * 68 + ar] = __uint_as_float(a.y << 16); As[(ak + 3) * 68 + ar] = __uint_as_float(a.y & 0xffff0000u);
#pragma unroll
        for (int j = 0; j < NB; ++j) *(float4*)&Bs[(j * 16 + bk) * 64 + bn] = *(const float4*)(Bp[j] + (size_t)(k0 + bk) * s.ldb + n0 + bn);
        __syncthreads();
#pragma unroll
        for (int kk = 0; kk < 16; ++kk) { const float4 a4 = *(const float4*)&As[kk * 68 + ty * 4]; const float aa[4] = {a4.x, a4.y, a4.z, a4.w};
#pragma unroll
            for (int j = 0; j < NB; ++j) { const float4 b4 = *(const float4*)&Bs[(j * 16 + kk) * 64 + tx * 4]; const float bb[4] = {b4.x, b4.y, b4.z, b4.w};
#pragma unroll
                for (int i = 0; i < 4; ++i)
#pragma unroll
                    for (int jj = 0; jj < 4; ++jj) acc[j][i][jj] += aa[i] * bb[jj]; } }
        __syncthreads();
    }
}
template <int NB, class Epi>
__global__ __launch_bounds__(256) void k_gemm(Stream s0, long long M, const int* seg, Epi epi) {
    __shared__ float As[16 * 68]; __shared__ float Bs[2 * 16 * 64];
    int rbase = 0, Ml = (int)M; size_t e = 0;
    if (seg) { e = blockIdx.z; rbase = seg[64 + e]; Ml = seg[e]; }
    const int m0 = blockIdx.y * 64, n0 = blockIdx.x * 64;
    if (m0 >= Ml) return;
    float acc0[NB][4][4] = {};
    gemm_accum<NB>(acc0, s0, e * s0.bstride, Ml, rbase, m0, n0, As, Bs);
    const int tx = threadIdx.x & 15, ty = threadIdx.x >> 4;
#pragma unroll
    for (int i = 0; i < 4; ++i) { const int r = m0 + ty * 4 + i; if (r >= Ml) continue;
#pragma unroll
        for (int j = 0; j < 4; ++j) { float a[2] = {0.f, 0.f};
#pragma unroll
            for (int b = 0; b < NB; ++b) a[b] = acc0[b][i][j];
            epi(rbase + r, n0 + tx * 4 + j, a); } }
}
struct EpiUG { bf16* UG; __device__ void operator()(int r, int c, const float* a) const { UG[ug_index(r, c)] = f2bf(a[0]); } };
struct EpiWc { bf16* WC; __device__ void operator()(int r, int c, const float* a) const { WC[(size_t)r * 512 + c] = f2bf(a[0] * a[1]); } };
struct EpiBf { bf16* O; int ldc; int pad; __device__ void operator()(int r, int c, const float* a) const { O[(size_t)r * ldc + c] = f2bf(a[0]); } };
struct EpiSig { bf16* SA; bf16* SB; __device__ void operator()(int r, int c, const float* a) const { const bf16 v = f2bf(sigmoidf_(a[0])); if (c < D) SA[(size_t)r * D + c] = v; else SB[(size_t)r * D + c - D] = v; } };
struct EpiGlu { bf16* TMP; const bf16* SA; __device__ void operator()(int r, int c, const float* a) const { TMP[(size_t)r * D + c] = f2bf(a[0] * sigmoidf_(a[1]) * bf2f(SA[(size_t)r * D + c])); } };
struct EpiCv { bf16* MG; const bf16* TMP; const bf16* SB; __device__ void operator()(int r, int c, const float* a) const { const size_t i = (size_t)r * D + c; MG[i] = f2bf(bf2f(TMP[i]) + bf2f(SB[i]) * a[0]); } };
struct EpiWo { float* Y1; const float* x; const float* mod; __device__ void operator()(int r, int c, const float* a) const { const size_t i = (size_t)r * D + c;
    Y1[i] = ALPHA * (x[i] + pos_emb(r & (L - 1), c)) + mod[(r / L) * 6144 + 2048 + c] * a[0]; } };
struct EpiHid { bf16* HID; __device__ void operator()(int r, int c, const float* a) const { HID[(size_t)r * FF + c] = f2bf(siluf_(a[0]) * a[1]); } };
struct EpiDown { bf16* Y2; const int* asg; const float* wgt; __device__ void operator()(int r, int c, const float* a) const { const int as = asg[r]; if (as >= 0) Y2[(size_t)as * D + c] = f2bf(wgt[as] * a[0]); } };

struct S5P { const float *log_dt, *a_re, *a_im, *b_re, *b_im, *c_re, *c_im; };
__global__ __launch_bounds__(64) void k_s5(S5P pf, S5P pb, const float* s5d, const bf16* UG, float* YF, bf16* YA) {
    const int b = blockIdx.x >> 5, g = blockIdx.x & 31, n = threadIdx.x;
    for (int dir = 0; dir < 2; ++dir) {
        const S5P& p = dir ? pb : pf;
        const float dt = expf(p.log_dt[g]); const float are = p.a_re[g * NS + n], aim = p.a_im[g * NS + n];
        const float mag = expf(dt * are); const float abr = mag * cosf(dt * aim), abi = mag * sinf(dt * aim);
        const float den = are * are + aim * aim, xr = abr - 1.f;
        const float fr = (xr * are + abi * aim) / den, fi = (abi * are - xr * aim) / den;
        float bbr[16], bbi[16], cr[16], ci[16];
#pragma unroll
        for (int c = 0; c < 16; ++c) { const float br = p.b_re[(g * NS + n) * 16 + c], bi = p.b_im[(g * NS + n) * 16 + c];
            bbr[c] = fr * br - fi * bi; bbi[c] = fr * bi + fi * br;
            cr[c] = p.c_re[(g * 16 + c) * NS + n]; ci[c] = p.c_im[(g * 16 + c) * NS + n]; }
        float sr = 0.f, si = 0.f;
        const float dd = n < 16 ? s5d[g * 16 + n] : 0.f;
        for (int i = 0; i < CTXL + L; ++i) {
            int r; if (i < CTXL) r = T + b * CTXL + (dir ? CTXL - 1 - i : i); else r = b * L + (dir ? L - 1 - (i - CTXL) : (i - CTXL));
            const bf16* u = UG + ug_index(r, g * 16);
            float br = 0.f, bi = 0.f;
#pragma unroll
            for (int c = 0; c < 16; ++c) { const float uu = bf2f(u[c]); br += bbr[c] * uu; bi += bbi[c] * uu; }
            const float nr = abr * sr - abi * si + br, ni = abr * si + abi * sr + bi; sr = nr; si = ni;
            if (i >= CTXL) {
                float mine = 0.f;
#pragma unroll
                for (int c = 0; c < 16; ++c) { const float v = wave_sum(cr[c] * sr - ci[c] * si); mine = (n == c) ? v : mine; }
                if (n < 16) { const size_t yi = (size_t)r * 512 + g * 16 + n;
                    if (dir == 0) YF[yi] = mine; else YA[yi] = f2bf(geluf_(YF[yi] + mine + dd * bf2f(u[n]))); } }
        }
    }
}

__global__ void k_conv(const bf16* WC, const bf16* GB, const float* conv_w, bf16* A2) { const size_t i = (size_t)blockIdx.x * blockDim.x + threadIdx.x; const size_t r = i >> 9; const int c = (int)(i & 511);
    const int p = (int)(r & 63);
    const float wm = p > 0 ? bf2f(WC[i - 512]) : 0.f, w0 = bf2f(WC[i]), wp = p < 63 ? bf2f(WC[i + 512]) : 0.f;
    A2[i] = f2bf(bf2f(GB[i]) * (conv_w[c] * wm + conv_w[512 + c] * w0 + conv_w[1024 + c] * wp)); }

__global__ __launch_bounds__(256) void k_lnmid(const float* mod, const float* g, const float* bta, float* Y1, bf16* H2) {
    const int r = blockIdx.x * 4 + (threadIdx.x >> 6), lane = threadIdx.x & 63; const int b = r / L;
    const float* md = mod + b * 6144; float v[16]; float s = 0.f;
#pragma unroll
    for (int i = 0; i < 16; ++i) { const int d = lane + 64 * i; v[i] = Y1[(size_t)r * D + d]; s += v[i]; }
    float mu = wave_sum(s) * (1.f / D), q = 0.f;
#pragma unroll
    for (int i = 0; i < 16; ++i) { v[i] -= mu; q += v[i] * v[i]; }
    float rstd = rsqrtf(wave_sum(q) * (1.f / D) + LN_EPS); s = 0.f;
#pragma unroll
    for (int i = 0; i < 16; ++i) { const int d = lane + 64 * i; v[i] = v[i] * rstd * g[d] + bta[d]; Y1[(size_t)r * D + d] = v[i]; s += v[i]; }
    mu = wave_sum(s) * (1.f / D); q = 0.f;
#pragma unroll
    for (int i = 0; i < 16; ++i) { v[i] -= mu; q += v[i] * v[i]; }
    rstd = rsqrtf(wave_sum(q) * (1.f / D) + LN_EPS);
#pragma unroll
    for (int i = 0; i < 16; ++i) { const int d = lane + 64 * i; H2[(size_t)r * D + d] = f2bf(v[i] * rstd * (1.f + md[4096 + d]) + md[3072 + d]); }
}

__global__ __launch_bounds__(256) void k_router(const bf16* H2, const float* Wg, const float* bg, const float* We, const float* be, int* eidx, float* wgt, int* counts) {
    const int t = blockIdx.x * 4 + (threadIdx.x >> 6), lane = threadIdx.x & 63;
    float lg[36];
#pragma unroll
    for (int j = 0; j < 36; ++j) lg[j] = 0.f;
    for (int i = 0; i < 16; ++i) { const int k = lane + 64 * i; const float h = bf2f(H2[(size_t)t * D + k]);
#pragma unroll
        for (int j = 0; j < 4; ++j) lg[j] += h * Wg[k * 4 + j];
#pragma unroll
        for (int j = 0; j < 32; ++j) lg[4 + j] += h * We[k * 32 + j]; }
    __shared__ float sl[4][40];
    float mine = 0.f;
#pragma unroll
    for (int j = 0; j < 36; ++j) { const float v = wave_sum(lg[j]); mine = (lane == j) ? v : mine; }
    if (lane < 4) mine += bg[lane]; else if (lane < 36) mine += be[lane - 4];
    if (lane < 36) sl[threadIdx.x >> 6][lane] = mine;
    __syncthreads();
    if (lane == 0) {
        const float* gl = sl[threadIdx.x >> 6];
        int gi = 0; float gm = gl[0];
        for (int j = 1; j < 4; ++j) { if (gl[j] > gm) { gm = gl[j]; gi = j; } }
        float gs = 0.f; for (int j = 0; j < 4; ++j) gs += expf(gl[j] - gm);
        const float pg = 1.f / gs;
        const float* el = gl + 4 + gi * 8;
        int i1 = 0; for (int j = 1; j < 8; ++j) if (el[j] > el[i1]) i1 = j;
        int i2 = (i1 == 0) ? 1 : 0; for (int j = 0; j < 8; ++j) if (j != i1 && el[j] > el[i2]) i2 = j;
        const float e2 = expf(el[i2] - el[i1]); const float w1 = pg / (1.f + e2), w2 = pg * e2 / (1.f + e2);
        eidx[2 * t] = gi * 8 + i1; eidx[2 * t + 1] = gi * 8 + i2; wgt[2 * t] = w1; wgt[2 * t + 1] = w2;
        atomicAdd(&counts[gi * 8 + i1], 1); atomicAdd(&counts[gi * 8 + i2], 1);
    }
}
__global__ void k_offsets(int* cnt) { if (threadIdx.x == 0) { int s = 0; for (int e = 0; e < 32; ++e) { cnt[64 + e] = s; s += (cnt[e] + 255) & ~255; cnt[32 + e] = 0; } cnt[96] = s; } }
__global__ void k_scatter(const int* eidx, int* cnt, int* tok, int* asg) { const int a = blockIdx.x * blockDim.x + threadIdx.x; const int e = eidx[a];
    const int p = atomicAdd(&cnt[32 + e], 1); const int s = cnt[64 + e] + p; tok[s] = a >> 1; asg[s] = a; }

__global__ __launch_bounds__(256) void k_final(const bf16* Y2, const float* mod, const float* g, const float* bta, float* out) {
    const int r = blockIdx.x * 4 + (threadIdx.x >> 6), lane = threadIdx.x & 63; const int b = r / L;
    const float* md = mod + b * 6144; float v[16]; float s = 0.f;
#pragma unroll
    for (int i = 0; i < 16; ++i) { const int d = lane + 64 * i; const float m = bf2f(Y2[(size_t)(2 * r) * D + d]) + bf2f(Y2[(size_t)(2 * r + 1) * D + d]);
        v[i] = ALPHA * out[(size_t)r * D + d] + md[5120 + d] * m; s += v[i]; }
    const float mu = wave_sum(s) * (1.f / D); float q = 0.f;
#pragma unroll
    for (int i = 0; i < 16; ++i) { v[i] -= mu; q += v[i] * v[i]; }
    const float rstd = rsqrtf(wave_sum(q) * (1.f / D) + LN_EPS);
#pragma unroll
    for (int i = 0; i < 16; ++i) { const int d = lane + 64 * i; out[(size_t)r * D + d] = v[i] * rstd * g[d] + bta[d]; }
}

#define LAS __attribute__((address_space(3)))
typedef short bf16x8 __attribute__((ext_vector_type(8)));
typedef float f32x4 __attribute__((ext_vector_type(4)));
typedef unsigned u32x4 __attribute__((ext_vector_type(4)));
typedef unsigned u32x2 __attribute__((ext_vector_type(2)));
constexpr int BM = 256, BK = 64, HALF = 128, HTB = HALF * BK * 2, STAGE_BYTES = 8 * HTB, NXCD = 8, WGM = 8;
__device__ __forceinline__ int lds_byte(int r, int c) { const int st = (r >> 4) * 2 + (c >> 5), rr = r & 15, cc = c & 31, ob = rr * 64 + cc * 2; return st * 1024 + (ob ^ (((ob >> 9) & 1) << 5)); }
__device__ __forceinline__ void stage_rc(int b, int& R, int& C) { const int st = b / 1024, sb = b % 1024, swz = sb ^ (((sb >> 9) & 1) << 5); R = (st >> 1) * 16 + swz / 64; C = (st & 1) * 32 + (swz % 64) / 2; }
__device__ __forceinline__ int perm32(int rho) { const int n = rho >> 4, i = rho & 15; return 8 * (i >> 2) + 4 * n + (i & 3); }
typedef float f32x2_t __attribute__((ext_vector_type(2)));
typedef __bf16 bf16x2_t __attribute__((ext_vector_type(2)));
__device__ __forceinline__ unsigned cvt_pk_bf16(float lo, float hi) { f32x2_t v = {lo, hi}; bf16x2_t b = __builtin_convertvector(v, bf16x2_t); return __builtin_bit_cast(unsigned, b); }
__device__ __forceinline__ f32x4 ldnt4(const float* p) { return __builtin_nontemporal_load((const f32x4*)p); }
__device__ __forceinline__ u32x4 ldnt4u(const bf16* p) { return __builtin_nontemporal_load((const u32x4*)p); }
__device__ __forceinline__ u32x2 ldnt2u(const bf16* p) { return __builtin_nontemporal_load((const u32x2*)p); }
__device__ __forceinline__ float fsigmoid(float x) { return __builtin_amdgcn_rcpf(1.f + __expf(-x)); }
__device__ __forceinline__ float blo(unsigned w) { return __uint_as_float(w << 16); }
__device__ __forceinline__ float bhi(unsigned w) { return __uint_as_float(w & 0xffff0000u); }

struct GUnit { const char* A; const char* B; const int* ridx; int pm, pn, aux0, aux1; };
__device__ __forceinline__ bool static_order(int i, int G, int c, int nM, int nN, int& pm, int& pn) {
    const int nwg = nM * nN; const long Lx = (long)i * G + c; if (Lx >= nwg) return false;
    int wgid = (int)Lx; { const int q = nwg / NXCD, r = nwg % NXCD, xcd = wgid % NXCD, off = wgid / NXCD; wgid = (xcd < r ? xcd * (q + 1) : r * (q + 1) + (xcd - r) * q) + off; }
    const int nig = WGM * nN, gid = wgid / nig, fm = gid * WGM, gsz = (nM - fm) < WGM ? (nM - fm) : WGM;
    pm = fm + ((wgid % nig) % gsz); pn = (wgid % nig) / gsz; return true;
}

template <class E_> struct EpiDup { static constexpr bool value = false; };
template <class Epi, class Sched, bool GATHER>
__device__ __forceinline__ void gemm_phase(LAS unsigned char* lds, const int K, const unsigned lda, const unsigned ldb, const Sched& S, const Epi& E) {
    const int tid = threadIdx.x, wid = __builtin_amdgcn_readfirstlane(tid >> 6), lane = tid & 63, wr = wid >> 2, wc = wid & 3, fr = lane & 15, fq = lane >> 4;
    const int nt = K / BK;
    int R0, C0, R1, C1; stage_rc(tid * 16, R0, C0); stage_rc(tid * 16 + 8192, R1, C1);
    const int Rb0 = (R0 & ~31) + perm32(R0 & 31), Rb1 = (R1 & ~31) + perm32(R1 & 31);
    const unsigned vB0 = (unsigned)Rb0 * ldb + C0 * 2, vB1 = (unsigned)Rb1 * ldb + C1 * 2; const size_t hB = (size_t)HALF * ldb;
    const size_t hA = GATHER ? (size_t)0 : (size_t)HALF * lda;
    unsigned vA[2][2], vAn[2][2];
#define PG_SETVA(dst, u) do { if constexpr (GATHER) { const int* _ri = (u).ridx; \
        dst[0][0] = (unsigned)_ri[R0] * lda + C0 * 2; dst[0][1] = (unsigned)_ri[R1] * lda + C1 * 2; dst[1][0] = (unsigned)_ri[128 + R0] * lda + C0 * 2; dst[1][1] = (unsigned)_ri[128 + R1] * lda + C1 * 2; } \
      else { dst[0][0] = (unsigned)R0 * lda + C0 * 2; dst[0][1] = (unsigned)R1 * lda + C1 * 2; dst[1][0] = dst[0][0]; dst[1][1] = dst[0][1]; } } while (0)
    const size_t kstep = (size_t)(BK * 2);
    const unsigned ldsw = (unsigned)wid * 1024u;
    const int aoff = lds_byte(wr * 64 + fr, fq * 8), boff = lds_byte(wc * 32 + fr, fq * 8);
#define PG_SA(b, h) (((b) * 2 + (h)) * HTB)
#define PG_SB(b, h) ((4 + (b) * 2 + (h)) * HTB)
#define PG_STAGE(bufoff, gbase, v0, v1) do { \
        __builtin_amdgcn_global_load_lds((const unsigned*)((const char*)(gbase) + (v0)), (LAS unsigned*)(lds + (bufoff) + ldsw), 16, 0, 0); \
        __builtin_amdgcn_global_load_lds((const unsigned*)((const char*)(gbase) + (v1)), (LAS unsigned*)(lds + (bufoff) + ldsw + 8192), 16, 0, 0); } while (0)
#define PG_LDA(dst, b, h) do { _Pragma("unroll") for (int m = 0; m < 4; ++m) _Pragma("unroll") for (int k = 0; k < 2; ++k) dst[m][k] = *(const LAS bf16x8*)(lds + PG_SA(b, h) + aoff + m * 2048 + k * 1024); } while (0)
#define PG_LDB(dst, b, h) do { _Pragma("unroll") for (int n = 0; n < 2; ++n) _Pragma("unroll") for (int k = 0; k < 2; ++k) dst[n][k] = *(const LAS bf16x8*)(lds + PG_SB(b, h) + boff + n * 2048 + k * 1024); } while (0)
#define PG_MMA(ai, bj, At, Bt) do { __builtin_amdgcn_s_setprio(1); _Pragma("unroll") for (int m = 0; m < 4; ++m) _Pragma("unroll") for (int n = 0; n < 2; ++n) _Pragma("unroll") for (int k = 0; k < 2; ++k) \
        acc[ai][bj][m][n] = __builtin_amdgcn_mfma_f32_16x16x32_bf16(Bt[n][k], At[m][k], acc[ai][bj][m][n], 0, 0, 0); __builtin_amdgcn_s_setprio(0); } while (0)
#define PG_WAIT_V(n) asm volatile("s_waitcnt vmcnt(" #n ")" ::: "memory")
#define PG_WAIT_L(n) asm volatile("s_waitcnt lgkmcnt(" #n ")" ::: "memory")
#define PG_BAR __builtin_amdgcn_s_barrier()
#define PG_SCHED __builtin_amdgcn_sched_barrier(0)
    GUnit cur, nxt; int ui = 0;
    if (!S.next(0, cur)) return;
    PG_SETVA(vA, cur);
    f32x4 acc[2][2][4][2];
#pragma unroll
    for (int a = 0; a < 2; ++a)
#pragma unroll
        for (int b = 0; b < 2; ++b)
#pragma unroll
            for (int m = 0; m < 4; ++m)
#pragma unroll
                for (int n = 0; n < 2; ++n) acc[a][b][m][n] = (f32x4){0.f, 0.f, 0.f, 0.f};
    bf16x8 At[4][2], B0[2][2], B1[2][2];
    const char* cA = cur.A; const char* cB = cur.B;
    PG_STAGE(PG_SB(0, 0), cB, vB0, vB1); PG_STAGE(PG_SB(0, 1), (cB) + hB, vB0, vB1); PG_STAGE(PG_SA(0, 0), cA, vA[0][0], vA[0][1]); PG_STAGE(PG_SA(0, 1), (cA) + hA, vA[1][0], vA[1][1]);
    if (wr == 1) PG_BAR;
    PG_WAIT_V(2); PG_BAR;
    PG_STAGE(PG_SB(1, 0), cB + kstep, vB0, vB1); PG_STAGE(PG_SA(1, 0), cA + kstep, vA[0][0], vA[0][1]); PG_STAGE(PG_SB(1, 1), (cB + kstep) + hB, vB0, vB1);
    PG_WAIT_V(6); PG_BAR;
    for (;;) {
        const bool has_next = S.next(ui + 1, nxt);
        const char* nA = has_next ? nxt.A : cA; const char* nB = has_next ? nxt.B : cB;
        if constexpr (GATHER) { if (has_next) PG_SETVA(vAn, nxt); else { vAn[0][0] = vA[0][0]; vAn[0][1] = vA[0][1]; vAn[1][0] = vA[1][0]; vAn[1][1] = vA[1][1]; } }
        for (int t = 0; t < nt; t += 2) {
            const bool last = (t == nt - 2);
            const char* a1 = cA + (size_t)(t + 1) * kstep;
            const char* a2 = last ? nA : cA + (size_t)(t + 2) * kstep; const char* b2 = last ? nB : cB + (size_t)(t + 2) * kstep;
            const char* a3 = a2 + kstep; const char* b3 = b2 + kstep;
            unsigned w00 = vA[0][0], w01 = vA[0][1], w10 = vA[1][0], w11 = vA[1][1];
            if constexpr (GATHER) { if (last) { w00 = vAn[0][0]; w01 = vAn[0][1]; w10 = vAn[1][0]; w11 = vAn[1][1]; } }
            PG_LDB(B0, 0, 0); PG_LDB(B1, 0, 1); PG_SCHED; PG_LDA(At, 0, 0); PG_STAGE(PG_SA(1, 1), (a1) + hA, vA[1][0], vA[1][1]);
            PG_WAIT_V(8); PG_WAIT_L(0); PG_BAR; PG_MMA(0, 0, At, B0); PG_MMA(0, 1, At, B1); PG_BAR; PG_SCHED;
            PG_LDA(At, 0, 1); PG_STAGE(PG_SB(0, 0), b2, vB0, vB1); PG_STAGE(PG_SB(0, 1), (b2) + hB, vB0, vB1); PG_STAGE(PG_SA(0, 0), a2, w00, w01);
            PG_WAIT_V(8); PG_WAIT_L(0); PG_BAR; PG_MMA(1, 0, At, B0); PG_MMA(1, 1, At, B1); PG_BAR; PG_SCHED;
            PG_LDB(B0, 1, 0); PG_LDB(B1, 1, 1); PG_SCHED; PG_LDA(At, 1, 0); PG_STAGE(PG_SA(0, 1), (a2) + hA, w10, w11);
            PG_WAIT_V(8); PG_WAIT_L(0); PG_BAR; PG_MMA(0, 0, At, B0); PG_MMA(0, 1, At, B1); PG_BAR; PG_SCHED;
            PG_LDA(At, 1, 1); PG_STAGE(PG_SB(1, 0), b3, vB0, vB1); PG_STAGE(PG_SB(1, 1), (b3) + hB, vB0, vB1); PG_STAGE(PG_SA(1, 0), a3, w00, w01);
            PG_WAIT_V(8); PG_WAIT_L(0); PG_BAR; PG_MMA(1, 0, At, B0); PG_MMA(1, 1, At, B1); PG_BAR; PG_SCHED;
        }
        if (wr == 0) PG_BAR;
        E(acc, cur, wr, wc, fr, fq);
        if constexpr (EpiDup<Epi>::value) { asm volatile("" ::: "memory"); E(acc, cur, wr, wc, fr, fq); }
        if (!has_next) break;
#pragma unroll
        for (int a = 0; a < 2; ++a)
#pragma unroll
            for (int b = 0; b < 2; ++b)
#pragma unroll
                for (int m = 0; m < 4; ++m)
#pragma unroll
                    for (int n = 0; n < 2; ++n) acc[a][b][m][n] = (f32x4){0.f, 0.f, 0.f, 0.f};
        cur = nxt; cA = nA; cB = nB; ++ui;
        if constexpr (GATHER) { vA[0][0] = vAn[0][0]; vA[0][1] = vAn[0][1]; vA[1][0] = vAn[1][0]; vA[1][1] = vAn[1][1]; }
        if (wr == 1) PG_BAR;
    }
    PG_WAIT_V(0);
    PG_BAR;
#undef PG_SETVA
#undef PG_SA
#undef PG_SB
#undef PG_STAGE
#undef PG_LDA
#undef PG_LDB
#undef PG_MMA
#undef PG_WAIT_V
#undef PG_WAIT_L
#undef PG_BAR
#undef PG_SCHED
}

constexpr int NWAVES = 8, NTHR = 512;
constexpr int LDS_BYTES = 147456;
constexpr int MISC_OFF = 146432;
constexpr long long FX_ONE = 1ll << 36;
constexpr int CW_BAR = 4096;
constexpr int CW_TILECTR = 15360;
constexpr int CW_MODACC = 16384;

#define XB_TMO      128
#define XB_XCNT(j)  (256  + 64 * (j))
#define XB_XSUB(j)  (1280 + 64 * (j))
#define XB_XGEN(j)  (2304 + 64 * (j))
#define XB_TOP      3328
#define XB_TOPGEN   3392
#define XCD_BAR_WORDS 3456
#define XB_SPIN_CAP (1u << 18)
__device__ __forceinline__ unsigned xb_ld(unsigned* p)              { return __hip_atomic_load(p, __ATOMIC_RELAXED, __HIP_MEMORY_SCOPE_AGENT); }
__device__ __forceinline__ unsigned xb_add(unsigned* p, unsigned v) { return __hip_atomic_fetch_add(p, v, __ATOMIC_RELAXED, __HIP_MEMORY_SCOPE_AGENT); }
__device__ __forceinline__ unsigned xb_xcc_id() { return (unsigned)__builtin_amdgcn_s_getreg((3 << 11) | 20) & 0xFu; }
#define XB_SPIN(cond, bar) do { unsigned _sp = 0; while (cond) { __builtin_amdgcn_s_sleep(1); \
    if ((++_sp & 255u) == 0u) { if (xb_ld(&(bar)[XB_TMO])) break; if (_sp > XB_SPIN_CAP) { atomicAdd(&(bar)[XB_TMO], 1u); break; } } } } while (0)
struct XcdBarrier { unsigned* bar; unsigned x; volatile LAS unsigned* st; };
__device__ __forceinline__ XcdBarrier xcd_barrier_post(unsigned* bar, volatile LAS unsigned* st) {
    XcdBarrier b; b.bar = bar; b.x = xb_xcc_id(); b.st = st;
    if (threadIdx.x == 0) (void)xb_add(&bar[XB_XCNT(b.x)], 1u);
    return b;
}
__device__ __forceinline__ void xcd_barrier_complete(unsigned* bar, unsigned x, unsigned& nloc, unsigned& nx) {
    const unsigned G = gridDim.x * gridDim.y * gridDim.z;
    unsigned sum, cnt, mine, sp = 0u;
    for (;;) {
        sum = 0u; cnt = 0u; mine = 0u;
#pragma unroll
        for (unsigned j = 0; j < 16; ++j) { const unsigned c = xb_ld(&bar[XB_XCNT(j)]); sum += c; cnt += (c > 0u) ? 1u : 0u; mine = (j == x) ? c : mine; }
        if (sum == G) break;
        __builtin_amdgcn_s_sleep(1);
        if ((++sp & 255u) == 0u) { if (xb_ld(&bar[XB_TMO])) break; if (sp > XB_SPIN_CAP) { atomicAdd(&bar[XB_TMO], 1u); break; } }
    }
    nloc = mine > 0u ? mine : 1u; nx = cnt > 0u ? cnt : 1u;
}
__device__ __forceinline__ void xcd_barrier(const XcdBarrier& b) {
    asm volatile("s_waitcnt vmcnt(0)" ::: "memory");
    __syncthreads();
    if (threadIdx.x == 0) {
        unsigned* bar = b.bar;
        __builtin_amdgcn_s_waitcnt(0);
        unsigned nloc = b.st[0], nx = b.st[1];
        if (nloc == 0u) { xcd_barrier_complete(bar, b.x, nloc, nx); b.st[0] = nloc; b.st[1] = nx; }
        const unsigned old = xb_add(&bar[XB_XSUB(b.x)], 1u);
        const unsigned gen = old / nloc;
        if (old + 1u == (gen + 1u) * nloc) {
            __builtin_amdgcn_fence(__ATOMIC_RELEASE, "agent");
            asm volatile("s_waitcnt vmcnt(0)" ::: "memory");
            const unsigned og = xb_add(&bar[XB_TOP], 1u);
            const unsigned tg = og / nx;
            if (og + 1u == (tg + 1u) * nx) xb_add(&bar[XB_TOPGEN], 1u);
            else XB_SPIN(xb_ld(&bar[XB_TOPGEN]) == tg, bar);
            __builtin_amdgcn_fence(__ATOMIC_ACQUIRE, "agent");
            xb_add(&bar[XB_XGEN(b.x)], 1u);
            asm volatile("s_waitcnt vmcnt(0)" ::: "memory");
        } else {
            XB_SPIN(xb_ld(&bar[XB_XGEN(b.x)]) == gen, bar);
            __builtin_amdgcn_fence(__ATOMIC_ACQUIRE, "agent");
            asm volatile("s_waitcnt vmcnt(0)" ::: "memory");
        }
    }
    __syncthreads();
}

struct Args { const float* in[38]; float* out; unsigned char* ws; int ph_lo, ph_hi, li, pad; };
__device__ __forceinline__ float wsum(float v) {
#pragma unroll
    for (int o = 1; o < 64; o <<= 1) v += __shfl_xor(v, o);
    return v;
}
__device__ __forceinline__ unsigned pk2(float lo, float hi) { return (unsigned)f2bf(lo) | ((unsigned)f2bf(hi) << 16); }

enum { MAP_ID = 0, MAP_WIN = 1, MAP_EVEN = 2, MAP_ODD = 3 };
template <int MAP> __device__ __forceinline__ int dst_row(int n) {
    if (MAP == MAP_EVEN) return 2 * n;
    if (MAP == MAP_ODD) return 2 * n + 1;
    if (MAP == MAP_WIN) { if (n < 512) return n; if (n < 1024) return 512 + 2 * (n - 512); if (n < 1536) return 1536 + (n - 1024); if (n < 2048) return 512 + 2 * (n - 1536) + 1; return n; }
    return n;
}
template <int MAP, bool NTST = false>
__device__ __forceinline__ void transpose_tile(const float* W, int K, int N, bf16* WT, LAS float* scr, int item, int lane) {
    const int nblk = N / 64, kb = item / nblk, nb = item % nblk, k0 = 64 * kb, n0 = 64 * nb;
    const int lr = lane >> 4, lc = (lane & 15) * 4;
    f32x4 v[16];
#pragma unroll
    for (int i = 0; i < 16; ++i) v[i] = ldnt4(W + (size_t)(k0 + 4 * i + lr) * N + n0 + lc);
#pragma unroll
    for (int i = 0; i < 16; ++i) { LAS float* d = scr + (4 * i + lr) * 65 + lc; d[0] = v[i][0]; d[1] = v[i][1]; d[2] = v[i][2]; d[3] = v[i][3]; }
    asm volatile("s_waitcnt lgkmcnt(0)" ::: "memory");
    const int c = lane & 7;
#pragma unroll
    for (int j = 0; j < 8; ++j) { const int n = (lane >> 3) + 8 * j; const LAS float* sp = scr + (8 * c) * 65 + n;
        u32x4 o; o.x = cvt_pk_bf16(sp[0 * 65], sp[1 * 65]); o.y = cvt_pk_bf16(sp[2 * 65], sp[3 * 65]); o.z = cvt_pk_bf16(sp[4 * 65], sp[5 * 65]); o.w = cvt_pk_bf16(sp[6 * 65], sp[7 * 65]);
        if (NTST) __builtin_nontemporal_store(o, (u32x4*)(WT + (size_t)dst_row<MAP>(n0 + n) * K + k0 + 8 * c)); else *(u32x4*)(WT + (size_t)dst_row<MAP>(n0 + n) * K + k0 + 8 * c) = o; }
    asm volatile("s_waitcnt lgkmcnt(0)" ::: "memory");
}

struct EpiInProj { bf16* UG; bf16* WC; bf16* GB; bf16* SA; bf16* SB;
    __device__ __forceinline__ void operator()(const f32x4 (&acc)[2][2][4][2], const GUnit& u, int wr, int wc, int fr, int fq) const {
        const int row0 = u.pm * BM + wr * 64 + fr, colb = u.pn * BM + wc * 32 + 8 * fq;
#pragma unroll
        for (int ai = 0; ai < 2; ++ai)
#pragma unroll
            for (int m = 0; m < 4; ++m) { const int row = row0 + ai * HALF + m * 16;
#pragma unroll
                for (int bj = 0; bj < 2; ++bj) { const int col = colb + bj * HALF; const f32x4 v0 = acc[ai][bj][m][0], v1 = acc[ai][bj][m][1];
                    if (u.pn < 2) { u32x4 w; w.x = cvt_pk_bf16(v0[0], v0[1]); w.y = cvt_pk_bf16(v0[2], v0[3]); w.z = cvt_pk_bf16(v1[0], v1[1]); w.w = cvt_pk_bf16(v1[2], v1[3]);
                        *(u32x4*)(UG + ug_index(row, col)) = w; }
                    else if (u.pn < 6) { u32x2 w; w.x = cvt_pk_bf16(v0[0] * v0[1], v0[2] * v0[3]); w.y = cvt_pk_bf16(v1[0] * v1[1], v1[2] * v1[3]);
                        *(u32x2*)(WC + (size_t)row * 512 + ((col - 512) >> 1)) = w; }
                    else if (u.pn < 8) { u32x4 w; w.x = cvt_pk_bf16(v0[0], v0[1]); w.y = cvt_pk_bf16(v0[2], v0[3]); w.z = cvt_pk_bf16(v1[0], v1[1]); w.w = cvt_pk_bf16(v1[2], v1[3]);
                        *(u32x4*)(GB + (size_t)row * 512 + (col - 1536)) = w; }
                    else { u32x4 w; w.x = cvt_pk_bf16(fsigmoid(v0[0]), fsigmoid(v0[1])); w.y = cvt_pk_bf16(fsigmoid(v0[2]), fsigmoid(v0[3])); w.z = cvt_pk_bf16(fsigmoid(v1[0]), fsigmoid(v1[1])); w.w = cvt_pk_bf16(fsigmoid(v1[2]), fsigmoid(v1[3]));
                        bf16* dst = (col < 3072) ? SA + (size_t)row * D + (col - 2048) : SB + (size_t)row * D + (col - 3072);
                        *(u32x4*)dst = w; } } }
    }
};
template <> struct EpiDup<EpiInProj> { static constexpr bool value = (DUPEPI & 1) != 0; };
struct SchedInProj { const char* XN; const char* WT; int G, c;
    __device__ __forceinline__ bool next(int i, GUnit& u) const {
        int pm, pn;
        if ((SDUP >> 2) & 1) { const int nc = 8; if (i >= 2 * nc) return false; if (i >= nc) i -= nc; }
        if (!static_order(i, G, c, 128, 16, pm, pn)) return false;
        u.pm = pm; u.pn = pn; u.A = XN + (size_t)pm * BM * (D * 2); u.B = WT + (size_t)pn * BM * (D * 2); u.ridx = nullptr; u.aux0 = 0; u.aux1 = 0; return true; }
};


struct MEpiGlu { bf16* TMP; const bf16* SA;
    __device__ __forceinline__ void operator()(const f32x4 (&acc)[2][2][4][2], const GUnit& u, int wr, int wc, int fr, int fq) const {
        const int row0 = u.pm * BM + wr * 64 + fr, colb = u.pn * BM + wc * 32 + 8 * fq;
        u32x2 sa[2][4][2];
#pragma unroll
        for (int ai = 0; ai < 2; ++ai)
#pragma unroll
            for (int m = 0; m < 4; ++m)
#pragma unroll
                for (int bj = 0; bj < 2; ++bj) sa[ai][m][bj] = ldnt2u(SA + (size_t)(row0 + ai * HALF + m * 16) * D + ((colb + bj * HALF) >> 1));
        __builtin_amdgcn_sched_barrier(0);
#pragma unroll
        for (int ai = 0; ai < 2; ++ai)
#pragma unroll
            for (int m = 0; m < 4; ++m) { const int row = row0 + ai * HALF + m * 16;
#pragma unroll
                for (int bj = 0; bj < 2; ++bj) { const int j0 = (colb + bj * HALF) >> 1; const f32x4 v0 = acc[ai][bj][m][0], v1 = acc[ai][bj][m][1]; const u32x2 q = sa[ai][m][bj];
                    u32x2 w; w.x = cvt_pk_bf16(v0[0] * fsigmoid(v0[1]) * blo(q.x), v0[2] * fsigmoid(v0[3]) * bhi(q.x)); w.y = cvt_pk_bf16(v1[0] * fsigmoid(v1[1]) * blo(q.y), v1[2] * fsigmoid(v1[3]) * bhi(q.y));
                    *(u32x2*)(TMP + (size_t)row * D + j0) = w; } }
    }
};
struct MEpiCv { bf16* MG; const bf16* TMP; const bf16* SB;
    __device__ __forceinline__ void operator()(const f32x4 (&acc)[2][2][4][2], const GUnit& u, int wr, int wc, int fr, int fq) const {
        const int row0 = u.pm * BM + wr * 64 + fr, colb = u.pn * BM + wc * 32 + 8 * fq;
#pragma unroll
        for (int ai = 0; ai < 2; ++ai) { u32x4 tt[4][2], ss[4][2];
#pragma unroll
            for (int m = 0; m < 4; ++m)
#pragma unroll
                for (int bj = 0; bj < 2; ++bj) { const size_t idx = (size_t)(row0 + ai * HALF + m * 16) * D + colb + bj * HALF; tt[m][bj] = ldnt4u(TMP + idx); ss[m][bj] = ldnt4u(SB + idx); }
            __builtin_amdgcn_sched_barrier(0);
#pragma unroll
            for (int m = 0; m < 4; ++m)
#pragma unroll
                for (int bj = 0; bj < 2; ++bj) { const size_t idx = (size_t)(row0 + ai * HALF + m * 16) * D + colb + bj * HALF; const f32x4 v0 = acc[ai][bj][m][0], v1 = acc[ai][bj][m][1]; const u32x4 t = tt[m][bj], sb = ss[m][bj];
                    u32x4 w; w.x = cvt_pk_bf16(blo(t.x) + blo(sb.x) * v0[0], bhi(t.x) + bhi(sb.x) * v0[1]); w.y = cvt_pk_bf16(blo(t.y) + blo(sb.y) * v0[2], bhi(t.y) + bhi(sb.y) * v0[3]);
                    w.z = cvt_pk_bf16(blo(t.z) + blo(sb.z) * v1[0], bhi(t.z) + bhi(sb.z) * v1[1]); w.w = cvt_pk_bf16(blo(t.w) + blo(sb.w) * v1[2], bhi(t.w) + bhi(sb.w) * v1[3]);
                    *(u32x4*)(MG + idx) = w; }
            __builtin_amdgcn_sched_barrier(0); }
    }
};
struct MEpiWo { bf16* MIXG; const float* MODF;
    __device__ __forceinline__ void operator()(const f32x4 (&acc)[2][2][4][2], const GUnit& u, int wr, int wc, int fr, int fq) const {
        const int row0 = u.pm * BM + wr * 64 + fr, colb = u.pn * BM + wc * 32 + 8 * fq;
        const float* g1 = MODF + (size_t)(u.pm * BM / L) * 6144 + 2048 + colb;
        f32x4 gg[2][2];
#pragma unroll
        for (int bj = 0; bj < 2; ++bj)
#pragma unroll
            for (int n = 0; n < 2; ++n) gg[bj][n] = *(const f32x4*)(g1 + bj * HALF + 4 * n);
#pragma unroll
        for (int ai = 0; ai < 2; ++ai)
#pragma unroll
            for (int m = 0; m < 4; ++m) { const int row = row0 + ai * HALF + m * 16;
#pragma unroll
                for (int bj = 0; bj < 2; ++bj) { const f32x4 v0 = acc[ai][bj][m][0] * gg[bj][0], v1 = acc[ai][bj][m][1] * gg[bj][1];
                    u32x4 w; w.x = cvt_pk_bf16(v0[0], v0[1]); w.y = cvt_pk_bf16(v0[2], v0[3]); w.z = cvt_pk_bf16(v1[0], v1[1]); w.w = cvt_pk_bf16(v1[2], v1[3]);
                    *(u32x4*)(MIXG + (size_t)row * D + colb + bj * HALF) = w; } }
    }
};
struct EpiLogit { float* LOGIT;
    __device__ __forceinline__ void operator()(const f32x4 (&acc)[2][2][4][2], const GUnit& u, int wr, int wc, int fr, int fq) const {
        if (wc >= 2) return;
        const int row0 = u.pm * BM + wr * 64 + fr, col = wc * 32 + 8 * fq;
#pragma unroll
        for (int ai = 0; ai < 2; ++ai)
#pragma unroll
            for (int m = 0; m < 4; ++m) { const int row = row0 + ai * HALF + m * 16;
                *(f32x4*)(LOGIT + (size_t)row * 64 + col) = acc[ai][0][m][0]; *(f32x4*)(LOGIT + (size_t)row * 64 + col + 4) = acc[ai][0][m][1]; }
    }
};
struct MEpiHid { bf16* HID;
    __device__ __forceinline__ void operator()(const f32x4 (&acc)[2][2][4][2], const GUnit& u, int wr, int wc, int fr, int fq) const {
        const int row0 = u.pm * BM + wr * 64 + fr, colb = u.pn * BM + wc * 32 + 8 * fq;
#pragma unroll
        for (int ai = 0; ai < 2; ++ai)
#pragma unroll
            for (int m = 0; m < 4; ++m) { const int row = row0 + ai * HALF + m * 16;
#pragma unroll
                for (int bj = 0; bj < 2; ++bj) { const int j0 = (colb + bj * HALF) >> 1; const f32x4 v0 = acc[ai][bj][m][0], v1 = acc[ai][bj][m][1];
                    u32x2 w; w.x = cvt_pk_bf16(v0[0] * fsigmoid(v0[0]) * v0[1], v0[2] * fsigmoid(v0[2]) * v0[3]); w.y = cvt_pk_bf16(v1[0] * fsigmoid(v1[0]) * v1[1], v1[2] * fsigmoid(v1[2]) * v1[3]);
                    *(u32x2*)(HID + (size_t)row * FF + j0) = w; } }
    }
};
struct MEpiDown { bf16* Y2; const int* asg; const float* wslot;
    __device__ __forceinline__ void operator()(const f32x4 (&acc)[2][2][4][2], const GUnit& u, int wr, int wc, int fr, int fq) const {
        if (NOEPI_DUP && u.aux1) return;
        const int row0 = u.pm * BM + wr * 64 + fr, colb = u.pn * BM + wc * 32 + 8 * fq;
        int as[2][4]; float wv[2][4];
#pragma unroll
        for (int ai = 0; ai < 2; ++ai)
#pragma unroll
            for (int m = 0; m < 4; ++m) { as[ai][m] = asg[row0 + ai * HALF + m * 16]; wv[ai][m] = wslot[row0 + ai * HALF + m * 16]; }
        __builtin_amdgcn_sched_barrier(0);
#pragma unroll
        for (int ai = 0; ai < 2; ++ai)
#pragma unroll
            for (int m = 0; m < 4; ++m) { const int a_ = as[ai][m];
                if (a_ >= 0) { const float w_ = wv[ai][m];
#pragma unroll
                    for (int bj = 0; bj < 2; ++bj) { const f32x4 v0 = acc[ai][bj][m][0] * w_, v1 = acc[ai][bj][m][1] * w_;
                        u32x4 w; w.x = cvt_pk_bf16(v0[0], v0[1]); w.y = cvt_pk_bf16(v0[2], v0[3]); w.z = cvt_pk_bf16(v1[0], v1[1]); w.w = cvt_pk_bf16(v1[2], v1[3]);
                        *(u32x4*)(Y2 + (size_t)a_ * D + colb + bj * HALF) = w; } } }
    }
};

struct EpiSend { float* SEND;
    __device__ __forceinline__ void operator()(const f32x4 (&acc)[2][2][4][2], const GUnit& u, int wr, int wc, int fr, int fq) const {
        const int row0 = u.pm * BM + wr * 64 + fr, colb = wc * 32 + 8 * fq; float* base = SEND + (size_t)u.aux0 * NCR * 256;
#pragma unroll
        for (int ai = 0; ai < 2; ++ai)
#pragma unroll
            for (int m = 0; m < 4; ++m) { const int row = row0 + ai * HALF + m * 16;
#pragma unroll
                for (int bj = 0; bj < 2; ++bj) { float* dst = base + (size_t)row * 256 + colb + bj * HALF; *(f32x4*)dst = acc[ai][bj][m][0]; *(f32x4*)(dst + 4) = acc[ai][bj][m][1]; } }
    }
};
struct SchedSend { const char* UG; const char* PM; int G, c;
    __device__ __forceinline__ bool next(int i, GUnit& u) const { if ((SDUP >> 3) & 1) { const int nc = (160 - c + G - 1) / G; if (nc <= 0 || i >= 2 * nc) return false; if (i >= nc) i -= nc; }
        const int Lx = i * G + c; if (Lx >= 160) return false; const int g = Lx / 5, pm = Lx % 5;
        u.pm = pm; u.pn = 0; u.aux0 = g; u.aux1 = 0; u.ridx = nullptr; u.A = UG + ((size_t)g * NCR + (size_t)pm * BM) * (UGK * 2); u.B = PM + (size_t)g * 256 * 512 * 2; return true; }
};
struct EpiY { bf16* YA;
    __device__ __forceinline__ void operator()(const f32x4 (&acc)[2][2][4][2], const GUnit& u, int wr, int wc, int fr, int fq) const {
        const int row0 = u.pm * BM + wr * 64 + fr, colb = u.pn * BM + wc * 32 + 8 * fq; const int g = u.aux0;
#pragma unroll
        for (int ai = 0; ai < 2; ++ai)
#pragma unroll
            for (int m = 0; m < 4; ++m) { const int crow = row0 + ai * HALF + m * 16;
#pragma unroll
                for (int bj = 0; bj < 2; ++bj) { const int col = colb + bj * HALF; const int to = col >> 4, co0 = col & 15; f32x4 v0 = acc[ai][bj][m][0], v1 = acc[ai][bj][m][1];
#pragma unroll
                    for (int k = 0; k < 4; ++k) { v0[k] = v0[k] * fsigmoid(1.5957691216f * (v0[k] + 0.044715f * v0[k] * v0[k] * v0[k])); v1[k] = v1[k] * fsigmoid(1.5957691216f * (v1[k] + 0.044715f * v1[k] * v1[k] * v1[k])); }
                    u32x4 w; w.x = cvt_pk_bf16(v0[0], v0[1]); w.y = cvt_pk_bf16(v0[2], v0[3]); w.z = cvt_pk_bf16(v1[0], v1[1]); w.w = cvt_pk_bf16(v1[2], v1[3]);
                    *(u32x4*)(YA + ((size_t)crow * 32 + to) * 512 + g * 16 + co0) = w; } }
    }
};
struct SchedY { const char* UG; const char* TM; int G, c;
    __device__ __forceinline__ bool next(int i, GUnit& u) const { if ((SDUP >> 5) & 1) { const int nc = (256 - c + G - 1) / G; if (nc <= 0 || i >= 2 * nc) return false; if (i >= nc) i -= nc; }
        const int Lx = i * G + c; if (Lx >= 256) return false; const int g = Lx >> 3, pm = (Lx >> 1) & 3, pn = Lx & 1;
        u.pm = pm; u.pn = pn; u.aux0 = g; u.aux1 = 0; u.ridx = nullptr; u.A = UG + ((size_t)g * NCR + (size_t)pm * BM) * (UGK * 2); u.B = TM + ((size_t)g * 512 + (size_t)pn * BM) * (UGK * 2); return true; }
};
template <> struct EpiDup<MEpiDown> { static constexpr bool value = (DUPEPI & 2) != 0; };
template <> struct EpiDup<MEpiHid> { static constexpr bool value = (DUPEPI & 4) != 0; };
struct SchedGrid { const char* A; const char* B; int G, c, nM, nN; unsigned lda, ldb; int dup;
    __device__ __forceinline__ bool next(int i, GUnit& u) const { int pm, pn;
        if (dup) { const int nc = (nM * nN - c + G - 1) / G; if (i >= 2 * nc) return false; if (i >= nc) i -= nc; }
        if (!static_order(i, G, c, nM, nN, pm, pn)) return false;
        u.pm = pm; u.pn = pn; u.A = A + (size_t)pm * BM * lda; u.B = B + (size_t)pn * BM * ldb; u.ridx = nullptr; u.aux0 = 0; u.aux1 = 0; return true; }
};
struct SchedGluPair { const char* A; const char* B; int G, c; int dup;
    __device__ __forceinline__ bool next(int i, GUnit& u) const { int pm, q;
        if (dup) { const int nc = 2 * ((512 - c + G - 1) / G); if (i >= 2 * nc) return false; if (i >= nc) i -= nc; }
        if (!static_order(i >> 1, G, c, 128, 4, pm, q)) return false;
        u.pm = pm; u.pn = 2 * q + (i & 1); u.A = A + (size_t)pm * BM * 1024u; u.B = B + (size_t)u.pn * BM * 1024u; u.ridx = nullptr; u.aux0 = 0; u.aux1 = 0; return true; }
};
struct SchedExp { const char* A; const char* W; const int* ridx; const int* meta; int G, c; unsigned lda, ldb; size_t wstride; int gather; int dup;
    __device__ __forceinline__ bool next(int i, GUnit& u) const { const int np = meta[32] >> 8;
        int isdup = 0; if (dup) { const int nc = (4 * np - c + G - 1) / G; if (i >= 2 * nc) return false; if (i >= nc) { i -= nc; isdup = 1; } }
        const int Lx = i * G + c; const int p = Lx >> 2, pn = Lx & 3; if (p >= np) return false;
        int e = 0;
#pragma unroll 1
        for (int k = 1; k < 32; ++k) e = (meta[k] <= (p << 8)) ? k : e;
        u.pm = p; u.pn = pn; u.A = gather ? A : A + (size_t)p * BM * lda; u.B = W + (size_t)e * wstride + (size_t)pn * BM * ldb; u.ridx = ridx + (p << 8); u.aux0 = e; u.aux1 = isdup; return true; }
};

__global__ void __launch_bounds__(NTHR, 2) fwd(Args args) {
    __shared__ __attribute__((aligned(1024))) unsigned char lds_raw[LDS_BYTES];
    LAS unsigned char* lds = (LAS unsigned char*)lds_raw;
    volatile LAS unsigned* MISC = (volatile LAS unsigned*)(lds + MISC_OFF);
    const int tid = threadIdx.x, lane = tid & 63, wave = __builtin_amdgcn_readfirstlane(tid >> 6);
    const int G = gridDim.x, bx = blockIdx.x;
    unsigned char* ws = args.ws;
    unsigned* ctl = (unsigned*)(ws + WS_CTL);
    for (int u = tid; u < (LDS_BYTES - MISC_OFF) / 4; u += NTHR) ((LAS unsigned*)(lds + MISC_OFF))[u] = 0u;
    __syncthreads();
    XcdBarrier bar = xcd_barrier_post(ctl + CW_BAR + args.li * XCD_BAR_WORDS, MISC + 8);
    const int lo = args.ph_lo, hi = args.ph_hi;
#define IN(k) (lo <= (k) && (k) < hi)
#define BOTH(k) (IN(k) && IN((k) + 1))
    const int gw = bx * NWAVES + wave, NGW = G * NWAVES;
    long long* modacc = (long long*)(ctl + CW_MODACC);
    float* MODF = (float*)(ws + WS_MOD);
    float* POSR = (float*)(ws + WS_POS); float* POSC = POSR + 128 * 512;
    bf16* Win_t = (bf16*)(ws + WS_WIN);
    bf16* XN = (bf16*)(ws + WS_RA); bf16* UG = (bf16*)(ws + WS_RB);
    bf16* WC = (bf16*)(ws + WS_RD); bf16* GB = (bf16*)(ws + WS_RD + 32 * MiB);
    bf16* SA = (bf16*)args.out; bf16* SB = SA + (size_t)T * D;
    bf16* Wglu_t = (bf16*)(ws + WS_WGLU); bf16* Wcv_t = (bf16*)(ws + WS_WCV); bf16* Wo_t = (bf16*)(ws + WS_WO); bf16* Wr_t = (bf16*)(ws + WS_WR); bf16* Wgu_t = (bf16*)(ws + WS_WGU); bf16* Wd_t = (bf16*)(ws + WS_WD);
    bf16* YA = (bf16*)(ws + WS_RD); bf16* A2 = (bf16*)(ws + WS_RD + 64 * MiB); bf16* TMP = (bf16*)(ws + WS_RA); bf16* MG = (bf16*)(ws + WS_RB);
    bf16* MIXG = (bf16*)(ws + WS_RD); bf16* X1B = (bf16*)(ws + WS_END);
    bf16* H2 = (bf16*)(ws + WS_RA); bf16* HID = (bf16*)(ws + WS_RB); bf16* Y2 = (bf16*)(ws + WS_RD); float* LOGIT = (float*)(ws + WS_LOGIT);
    unsigned char* rt = ws + WS_ROUT; int* eidx = (int*)(rt + RT_EIDX); float* wgt = (float*)(rt + RT_WGT); int* tokl = (int*)(rt + RT_TOK); int* asgl = (int*)(rt + RT_ASG);
    float* TAPG = (float*)(ws + WS_LOGIT); float* PWG = (float*)(ws + WS_LOGIT + 2 * MiB); float* BBG = (float*)(ws + WS_LOGIT + 4 * MiB);
    bf16* Pm = (bf16*)(ws + WS_PM); bf16* Tm = (bf16*)(ws + WS_TM); float* SEND = (float*)(ws + WS_RA);
    float* wsl = (float*)(rt + RT_META + 64 * 1024);
    int* hist = (int*)(rt + RT_HIST); int* rankl = (int*)(rt + RT_RANK); int* meta = (int*)(rt + RT_META);

    if (IN(0)) {
        for (int rep_ = 0; rep_ < ((DUPMASK >> 0) & 1) + 1; ++rep_) {
        for (int r4_ = 0; r4_ < ((DUPMASK >> 18) & 1) + 1; ++r4_)
        if (rep_ == 0) {
            const float* w_ada = args.in[4];
            for (int it = gw; it < 96 * 16; it += NGW) { const int ct = it % 96, ks = it / 96; const int col = ct * 64 + lane, k0 = ks * 64;
                float cvv[5], wv[64];
#pragma unroll
                for (int v = 0; v < 5; ++v) cvv[v] = (v < 4) ? args.in[1][v * 1024 + k0 + lane] : args.in[3][k0 + lane];
#pragma unroll
                for (int k = 0; k < 64; ++k) wv[k] = __builtin_nontemporal_load(w_ada + (size_t)(k0 + k) * 6144 + col);
                __builtin_amdgcn_sched_barrier(0);
                float sv[5];
#pragma unroll
                for (int v = 0; v < 5; ++v) sv[v] = cvv[v] * fsigmoid(cvv[v]);
                float a0 = 0.f, a1 = 0.f, a2 = 0.f, a3 = 0.f, a4 = 0.f;
#pragma unroll
                for (int k = 0; k < 64; ++k) { const float w = wv[k];
                    a0 += __builtin_bit_cast(float, __builtin_amdgcn_readlane(__builtin_bit_cast(int, sv[0]), k)) * w; a1 += __builtin_bit_cast(float, __builtin_amdgcn_readlane(__builtin_bit_cast(int, sv[1]), k)) * w;
                    a2 += __builtin_bit_cast(float, __builtin_amdgcn_readlane(__builtin_bit_cast(int, sv[2]), k)) * w; a3 += __builtin_bit_cast(float, __builtin_amdgcn_readlane(__builtin_bit_cast(int, sv[3]), k)) * w;
                    a4 += __builtin_bit_cast(float, __builtin_amdgcn_readlane(__builtin_bit_cast(int, sv[4]), k)) * w; }
                const float sc = (float)FX_ONE;
                __hip_atomic_fetch_add(modacc + r4_ * 30720 + 0 * 6144 + col, (long long)(a0 * sc), __ATOMIC_RELAXED, __HIP_MEMORY_SCOPE_AGENT);
                __hip_atomic_fetch_add(modacc + r4_ * 30720 + 1 * 6144 + col, (long long)(a1 * sc), __ATOMIC_RELAXED, __HIP_MEMORY_SCOPE_AGENT);
                __hip_atomic_fetch_add(modacc + r4_ * 30720 + 2 * 6144 + col, (long long)(a2 * sc), __ATOMIC_RELAXED, __HIP_MEMORY_SCOPE_AGENT);
                __hip_atomic_fetch_add(modacc + r4_ * 30720 + 3 * 6144 + col, (long long)(a3 * sc), __ATOMIC_RELAXED, __HIP_MEMORY_SCOPE_AGENT);
                __hip_atomic_fetch_add(modacc + r4_ * 30720 + 4 * 6144 + col, (long long)(a4 * sc), __ATOMIC_RELAXED, __HIP_MEMORY_SCOPE_AGENT); }
        }
        for (int i = bx * NTHR + tid; i < 192 * 512; i += G * NTHR) {
            const int p = i >> 9, d = i & 511; const int pp = p < 128 ? p : p - 128; const int ii = d & 255;
            const float omega = exp2f(-(float)ii * (13.287712379549449f / 256.0f)); const float a = (float)pp * omega;
            POSR[i] = (d < 256) ? sinf(a) : cosf(a); }
        const bool s5blk = (G == 256) ? ((bx & 3) == ((bx >> 2) & 3)) : (bx < 64);
        __syncthreads();
        for (int r2_ = 0; r2_ < ((DUPMASK >> 16) & 1) + 1; ++r2_)
        if (s5blk) {
            const int item = (G == 256) ? (bx >> 2) : bx; const int g = item >> 1, d = item & 1, pb = d ? 14 : 7;
            LAS float* PW = (LAS float*)lds;
            LAS float* BB = PW + 4224;
            LAS float* CC = BB + 2048;
            LAS float* LT = CC + 2048;
            if (tid < 64) { const int n = tid;
                const float dt = expf(args.in[pb][g]); const float are = args.in[pb + 1][g * NS + n], aim = args.in[pb + 2][g * NS + n];
                const float lnm = dt * are, th = dt * aim; const float mag = expf(lnm); const float abr = mag * cosf(th), abi = mag * sinf(th);
                const float den = are * are + aim * aim, xr = abr - 1.f; const float fr_ = (xr * are + abi * aim) / den, fi_ = (abi * are - xr * aim) / den;
                LT[n * 2] = lnm; LT[n * 2 + 1] = th;
                f32x4 brv[4], biv[4];
#pragma unroll
                for (int q = 0; q < 4; ++q) { brv[q] = *(const f32x4*)(args.in[pb + 3] + (g * NS + n) * 16 + 4 * q); biv[q] = *(const f32x4*)(args.in[pb + 4] + (g * NS + n) * 16 + 4 * q); }
                __builtin_amdgcn_sched_barrier(0);
#pragma unroll
                for (int q = 0; q < 4; ++q)
#pragma unroll
                    for (int k = 0; k < 4; ++k) { const int c = 4 * q + k; const float br = brv[q][k], bi = biv[q][k]; const float vr = fr_ * br - fi_ * bi, vi = fr_ * bi + fi_ * br;
                        BB[(n * 16 + c) * 2] = vr; BB[(n * 16 + c) * 2 + 1] = vi; BBG[((size_t)item * 1024 + n * 16 + c) * 2] = vr; BBG[((size_t)item * 1024 + n * 16 + c) * 2 + 1] = vi; } }
            { float cr_[2], ci_[2];
#pragma unroll
              for (int q = 0; q < 2; ++q) { const int i = tid + q * NTHR; cr_[q] = args.in[pb + 5][g * 1024 + i]; ci_[q] = args.in[pb + 6][g * 1024 + i]; }
              __builtin_amdgcn_sched_barrier(0);
#pragma unroll
              for (int q = 0; q < 2; ++q) { const int i = tid + q * NTHR; CC[i * 2] = cr_[q]; CC[i * 2 + 1] = ci_[q]; } }
            __syncthreads();
            for (int i = tid; i < 33 * 64; i += NTHR) { const int n = i & 63, j = i >> 6; const float lnm = LT[n * 2], th = LT[n * 2 + 1];
                const float mj = __expf((float)j * lnm); const float vr = mj * __cosf((float)j * th), vi = mj * __sinf((float)j * th);
                PW[i * 2] = vr; PW[i * 2 + 1] = vi; PWG[((size_t)item * 2112 + i) * 2] = vr; PWG[((size_t)item * 2112 + i) * 2 + 1] = vi; }
            __syncthreads();
            { const int j = tid >> 4, co = tid & 15; float ta[16];
#pragma unroll
              for (int c = 0; c < 16; ++c) ta[c] = 0.f;
              const LAS float* pwp = PW + (j * 64) * 2; const LAS float* ccp = CC + (co * 64) * 2; const LAS f32x4* bbp = (const LAS f32x4*)BB;
#pragma unroll 2
              for (int n = 0; n < 64; ++n) { const float pr = pwp[2 * n], pi = pwp[2 * n + 1], cr = ccp[2 * n], ci = ccp[2 * n + 1];
                  const float cpr = cr * pr - ci * pi, cpi = cr * pi + ci * pr;
#pragma unroll
                  for (int q = 0; q < 8; ++q) { const f32x4 b = bbp[n * 8 + q]; ta[2 * q] += cpr * b[0] - cpi * b[1]; ta[2 * q + 1] += cpr * b[2] - cpi * b[3]; } }
              float* tg = TAPG + ((size_t)item * 32 + j) * 256 + co * 16;
#pragma unroll
              for (int q = 0; q < 4; ++q) *(f32x4*)(tg + 4 * q) = (f32x4){ta[4 * q], ta[4 * q + 1], ta[4 * q + 2], ta[4 * q + 3]}; }
            __syncthreads();
        }
        {
            LAS float* scr = (LAS float*)(lds + wave * 16640);
            const int s5rank = (G == 256) ? (bx >> 2) : bx, orank = (G == 256) ? (bx - ((bx >> 2) + (((bx & 3) > ((bx >> 2) & 3)) ? 1 : 0))) : (bx - 64);
            const int t_lo = s5blk ? 0 : 2048, t_hi = s5blk ? 2048 : 13952, t_first = t_lo + (s5blk ? s5rank : orank) * NWAVES + wave, t_step = (s5blk ? 64 : (G - 64)) * NWAVES;
            for (int r3_ = 0; r3_ < ((DUPMASK >> 17) & 1) + 1; ++r3_)
            {
            for (int it = t_first; it < t_hi; it += t_step) {
                int r = it;
                if (r < 1024) { transpose_tile<MAP_WIN>(args.in[6], D, INW, Win_t, scr, r, lane); }
                else if ((r -= 1024) < 128) { transpose_tile<MAP_EVEN>(args.in[22], 512, D, Wglu_t, scr, r, lane); }
                else if ((r -= 128) < 128) { transpose_tile<MAP_ODD>(args.in[23], 512, D, Wglu_t, scr, r, lane); }
                else if ((r -= 128) < 128) { transpose_tile<MAP_ID>(args.in[25], 512, D, Wcv_t, scr, r, lane); }
                else if ((r -= 128) < 256) { transpose_tile<MAP_ID>(args.in[26], D, D, Wo_t, scr, r, lane); }
                else if ((r -= 256) < 4096) { const int e = r >> 7; transpose_tile<MAP_EVEN, true>(args.in[33] + (size_t)e * D * FF, D, FF, Wgu_t + (size_t)e * D * D, scr, r & 127, lane); }
                else if ((r -= 4096) < 4096) { const int e = r >> 7; transpose_tile<MAP_ODD, true>(args.in[34] + (size_t)e * D * FF, D, FF, Wgu_t + (size_t)e * D * D, scr, r & 127, lane); }
                else { r -= 4096; const int e = r >> 7; transpose_tile<MAP_ID, true>(args.in[35] + (size_t)e * FF * D, FF, D, Wd_t + (size_t)e * D * FF, scr, r & 127, lane); }
            }
            }
            for (int i = bx * NTHR + tid; i < 256 * D; i += G * NTHR) { const int n = i >> 10, k = i & 1023;
                const float v = (n < 4) ? args.in[29][k * 4 + n] : (n < 36) ? args.in[31][k * 32 + (n - 4)] : 0.f; Wr_t[i] = f2bf(v); }
        }
        }
        if (BOTH(0)) { xcd_barrier(bar); if (DUPBAR) xcd_barrier(bar); }
    }
    if (IN(1)) {
        for (int rep_ = 0; rep_ < ((DUPMASK >> 1) & 1) + 1; ++rep_) {
        for (int item = bx; item < 256; item += G) {
            const int g = item >> 3, part = item & 7;
            LAS float* PW = (LAS float*)lds;
            LAS float* BB = PW + 8448;
            LAS float* CC = BB + 4096;
            LAS float* TAP = CC + 4096;
            LAS float* DK = TAP + 16384;
            if (part < 4) {
                f32x4 t8[8];
#pragma unroll
                for (int q = 0; q < 8; ++q) t8[q] = *(const f32x4*)(TAPG + (size_t)g * 16384 + (size_t)(q * NTHR + tid) * 4);
                __builtin_amdgcn_sched_barrier(0);
#pragma unroll
                for (int q = 0; q < 8; ++q) *(LAS f32x4*)(TAP + (q * NTHR + tid) * 4) = t8[q];
                if (tid < 16) DK[tid] = args.in[21][g * 16 + tid];
                __syncthreads();
                for (int idx = tid; idx < 128 * 256; idx += NTHR) { const int rl = idx >> 8, kp = idx & 255; const int row = 128 * part + rl, to = row >> 4, co = row & 15, k = 2 * kp, ti = k >> 4, ci = k & 15;
                    float v0 = 0.f, v1 = 0.f;
                    if (to >= ti) { v0 += TAP[(to - ti) * 256 + co * 16 + ci]; v1 += TAP[(to - ti) * 256 + co * 16 + ci + 1]; }
                    if (to <= ti) { v0 += TAP[(32 + ti - to) * 256 + co * 16 + ci]; v1 += TAP[(32 + ti - to) * 256 + co * 16 + ci + 1]; }
                    if (to == ti) { const float dk = DK[co]; if (co == ci) v0 += dk; if (co == ci + 1) v1 += dk; }
                    *(unsigned*)(Tm + ((size_t)g * 512 + row) * UGK + k) = pk2(v0, v1); }
            } else if (part < 6) {
                for (int i = tid; i < 2112; i += NTHR) *(LAS f32x4*)(PW + i * 4) = *(const f32x4*)(PWG + (size_t)g * 8448 + (size_t)i * 4);
                { float cr_[4], ci_[4];
#pragma unroll
                  for (int q = 0; q < 4; ++q) { const int i = tid + q * NTHR; const int d = i >> 10, rem = i & 1023; const int pb = d ? 14 : 7; cr_[q] = args.in[pb + 5][g * 1024 + rem]; ci_[q] = args.in[pb + 6][g * 1024 + rem]; }
                  __builtin_amdgcn_sched_barrier(0);
#pragma unroll
                  for (int q = 0; q < 4; ++q) { const int i = tid + q * NTHR; CC[i * 2] = cr_[q]; CC[i * 2 + 1] = ci_[q]; } }
                __syncthreads();
                for (int idx = tid; idx < 256 * 128; idx += NTHR) { const int rl = idx >> 7, kp = idx & 127; const int row = 256 * (part - 4) + rl, to = row >> 4, co = row & 15, kk = 2 * kp, d = kk >> 7, reim = (kk >> 6) & 1, n = kk & 63;
                    const int j = d ? 32 - to : to + 1; float vv[2];
#pragma unroll
                    for (int q = 0; q < 2; ++q) { const float pr = PW[((d * 33 + j) * 64 + n + q) * 2], pi = PW[((d * 33 + j) * 64 + n + q) * 2 + 1], cr = CC[((d * 16 + co) * 64 + n + q) * 2], ci = CC[((d * 16 + co) * 64 + n + q) * 2 + 1];
                        vv[q] = reim ? -(cr * pi + ci * pr) : (cr * pr - ci * pi); }
                    *(unsigned*)(Tm + ((size_t)g * 512 + row) * UGK + 512 + kk) = pk2(vv[0], vv[1]); }
            } else {
                const int d = part - 6;
                for (int i = tid; i < 1056; i += NTHR) *(LAS f32x4*)(PW + d * 4224 + i * 4) = *(const f32x4*)(PWG + ((size_t)g * 2 + d) * 4224 + (size_t)i * 4);
                *(LAS f32x4*)(BB + d * 2048 + tid * 4) = *(const f32x4*)(BBG + ((size_t)g * 2 + d) * 2048 + (size_t)tid * 4);
                __syncthreads();
                for (int idx = tid; idx < 128 * 256; idx += NTHR) { const int rl = idx >> 8, kp = idx & 255; const int reim = rl >> 6, n = rl & 63, k = 2 * kp, t = k >> 4, ci = k & 15; const int j = d ? t : 31 - t;
                    const float pr = PW[((d * 33 + j) * 64 + n) * 2], pi = PW[((d * 33 + j) * 64 + n) * 2 + 1]; float vv[2];
#pragma unroll
                    for (int q = 0; q < 2; ++q) { const float br = BB[((d * 64 + n) * 16 + ci + q) * 2], bi = BB[((d * 64 + n) * 16 + ci + q) * 2 + 1]; vv[q] = reim ? (pr * bi + pi * br) : (pr * br - pi * bi); }
                    *(unsigned*)(Pm + ((size_t)g * 256 + d * 128 + rl) * 512 + k) = pk2(vv[0], vv[1]); }
            }
            __syncthreads();
        }
        for (int i = bx * NTHR + tid; i < 5 * 6144; i += G * NTHR) MODF[i] = (float)((double)__hip_atomic_load(modacc + i, __ATOMIC_RELAXED, __HIP_MEMORY_SCOPE_AGENT) * (1.0 / (double)FX_ONE)) + args.in[5][i % 6144];
        LAS float* shs = (LAS float*)lds;
        const int bat = bx / (G / 4);
        for (int i = tid; i < 4096; i += NTHR) { const int which = i >> 11, c = i & 2047; const int mv = which ? 4 : bat;
            shs[i] = (float)((double)__hip_atomic_load(modacc + mv * 6144 + c, __ATOMIC_RELAXED, __HIP_MEMORY_SCOPE_AGENT) * (1.0 / (double)FX_ONE)) + args.in[5][c]; }
        __syncthreads();
        const int rows_per_blk = T / G;
        for (int it = 0; it < rows_per_blk / (2 * NWAVES); ++it) {
            f32x4 v[2][4], pe[2][4];
#pragma unroll
            for (int h = 0; h < 2; ++h) { const int r = bx * rows_per_blk + wave + 16 * it + 8 * h; const int l = r & (L - 1); const float* pr = POSR + (l >> 6) * 512; const float* pc = POSC + (l & 63) * 512;
#pragma unroll
                for (int j = 0; j < 4; ++j) { const int d0 = 256 * j + 4 * lane; v[h][j] = ldnt4(args.in[0] + (size_t)r * D + d0); pe[h][j] = (j < 2) ? *(const f32x4*)(pr + d0) : *(const f32x4*)(pc + d0 - 512); } }
            __builtin_amdgcn_sched_barrier(0);
#pragma unroll
            for (int h = 0; h < 2; ++h) { const int r = bx * rows_per_blk + wave + 16 * it + 8 * h; float s = 0.f;
#pragma unroll
                for (int j = 0; j < 4; ++j) { v[h][j] += pe[h][j]; s += (v[h][j][0] + v[h][j][1]) + (v[h][j][2] + v[h][j][3]); }
                const float mean = wsum(s) * (1.f / D); float s2 = 0.f;
#pragma unroll
                for (int j = 0; j < 4; ++j) { v[h][j] = v[h][j] - mean; s2 += (v[h][j][0] * v[h][j][0] + v[h][j][1] * v[h][j][1]) + (v[h][j][2] * v[h][j][2] + v[h][j][3] * v[h][j][3]); }
                const float rstd = rsqrtf(wsum(s2) * (1.f / D) + LN_EPS);
#pragma unroll
                for (int j = 0; j < 4; ++j) { const int d0 = 256 * j + 4 * lane; const f32x4 hh = *(const LAS f32x4*)(shs + d0), cc = *(const LAS f32x4*)(shs + 1024 + d0);
                    const f32x4 o = v[h][j] * rstd * (cc + 1.0f) + hh; u32x2 w; w.x = cvt_pk_bf16(o[0], o[1]); w.y = cvt_pk_bf16(o[2], o[3]);
                    *(u32x2*)(XN + (size_t)r * D + d0) = w; } }
        }
        for (int task = bx; task < 256; task += G) {
            const int c0 = 16 * (task >> 2), nn0 = 128 * (task & 3) + 16 * wave; const LAS float* sh = shs + 2048;
#pragma unroll 1
            for (int rr = 0; rr < 2; ++rr) { const int r = T + c0 + 2 * wave + rr; const float* src = args.in[2] + (size_t)(r - T) * D;
                f32x4 v[4]; float s = 0.f;
#pragma unroll
                for (int j = 0; j < 4; ++j) { v[j] = *(const f32x4*)(src + 256 * j + 4 * lane); }
#pragma unroll
                for (int j = 0; j < 4; ++j) s += (v[j][0] + v[j][1]) + (v[j][2] + v[j][3]);
                const float mean = wsum(s) * (1.f / D); float s2 = 0.f;
#pragma unroll
                for (int j = 0; j < 4; ++j) { v[j] = v[j] - mean; s2 += (v[j][0] * v[j][0] + v[j][1] * v[j][1]) + (v[j][2] * v[j][2] + v[j][3] * v[j][3]); }
                const float rstd = rsqrtf(wsum(s2) * (1.f / D) + LN_EPS);
#pragma unroll
                for (int j = 0; j < 4; ++j) { const int d0 = 256 * j + 4 * lane; const f32x4 hh = *(const LAS f32x4*)(sh + d0), cc = *(const LAS f32x4*)(sh + 1024 + d0);
                    const f32x4 o = v[j] * rstd * (cc + 1.0f) + hh; u32x2 w; w.x = cvt_pk_bf16(o[0], o[1]); w.y = cvt_pk_bf16(o[2], o[3]);
                    *(u32x2*)(XN + (size_t)r * D + d0) = w; } }
            asm volatile("s_waitcnt vmcnt(0)" ::: "memory");
            __syncthreads();
            { const int m = lane & 15, q = lane >> 4; const bf16* arow = XN + (size_t)(T + c0 + m) * D + 8 * q; const bf16* brow = Win_t + (size_t)(nn0 + m) * D + 8 * q;
              f32x4 cacc = (f32x4){0.f, 0.f, 0.f, 0.f};
#pragma unroll 1
              for (int cb = 0; cb < 4; ++cb) { bf16x8 af[8], bfv[8];
#pragma unroll
                  for (int c = 0; c < 8; ++c) { af[c] = *(const bf16x8*)(arow + 32 * (8 * cb + c)); bfv[c] = *(const bf16x8*)(brow + 32 * (8 * cb + c)); }
                  __builtin_amdgcn_sched_barrier(0);
#pragma unroll
                  for (int c = 0; c < 8; ++c) cacc = __builtin_amdgcn_mfma_f32_16x16x32_bf16(af[c], bfv[c], cacc, 0, 0, 0); }
#pragma unroll
              for (int i = 0; i < 4; ++i) UG[ug_index(T + c0 + 4 * q + i, nn0 + m)] = f2bf(cacc[i]); }
            __syncthreads();
        }
        }
        if (BOTH(1)) { xcd_barrier(bar); if (DUPBAR) xcd_barrier(bar); }
    }
    if (IN(2)) {
        for (int rep_ = 0; rep_ < ((DUPMASK >> 2) & 1) + 1; ++rep_) {
        EpiInProj E{UG, WC, GB, SA, SB};
        SchedInProj S{(const char*)XN, (const char*)Win_t, G, bx};
        gemm_phase<EpiInProj, SchedInProj, false>(lds, D, D * 2, D * 2, S, E);
        }
        if (BOTH(2)) { xcd_barrier(bar); if (DUPBAR) xcd_barrier(bar); }
    }

    if (IN(3)) {
        for (int rep_ = 0; rep_ < ((DUPMASK >> 3) & 1) + 1; ++rep_) {
        { SchedSend S{(const char*)UG, (const char*)Pm, G, bx}; EpiSend E{SEND};
          gemm_phase<EpiSend, SchedSend, false>(lds, 512, UGK * 2, 1024u, S, E); }
        { const int c0 = (tid & 63) * 8; float cw[3][8];
#pragma unroll
          for (int q = 0; q < 3; ++q)
#pragma unroll
              for (int k = 0; k < 8; ++k) cw[q][k] = args.in[24][q * 512 + c0 + k];
          const int rows_per_blk = T / G;
          for (int rr = tid >> 6; rr < rows_per_blk; rr += NWAVES) { const int r = bx * rows_per_blk + rr; const int p = r & 63; const size_t idx = (size_t)r * 512 + c0;
              const u32x4 z = {0u, 0u, 0u, 0u};
              const u32x4 wm = (p > 0) ? *(const u32x4*)(WC + idx - 512) : z, w0 = *(const u32x4*)(WC + idx), wp = (p < 63) ? *(const u32x4*)(WC + idx + 512) : z, gb = ldnt4u(GB + idx);
              float o[8];
#pragma unroll
              for (int k = 0; k < 4; ++k) { const unsigned a = wm[k], b = w0[k], c = wp[k], g_ = gb[k];
                  o[2 * k] = blo(g_) * (cw[0][2 * k] * blo(a) + cw[1][2 * k] * blo(b) + cw[2][2 * k] * blo(c));
                  o[2 * k + 1] = bhi(g_) * (cw[0][2 * k + 1] * bhi(a) + cw[1][2 * k + 1] * bhi(b) + cw[2][2 * k + 1] * bhi(c)); }
              u32x4 w; w.x = cvt_pk_bf16(o[0], o[1]); w.y = cvt_pk_bf16(o[2], o[3]); w.z = cvt_pk_bf16(o[4], o[5]); w.w = cvt_pk_bf16(o[6], o[7]);
              *(u32x4*)(A2 + idx) = w; } }
        }
        if (BOTH(3)) { xcd_barrier(bar); if (DUPBAR) xcd_barrier(bar); }
    }
    if (IN(4)) {
        for (int rep_ = 0; rep_ < ((DUPMASK >> 4) & 1) + 1; ++rep_) {
        LAS float* seg = (LAS float*)lds;
        for (int item = bx; item < 256; item += G) {
            const int b = item >> 6, d = (item >> 5) & 1, g = item & 31, n = lane; const int pb = d ? 14 : 7;
            const float dt = expf(args.in[pb][g]); const float lnm = dt * args.in[pb + 1][g * NS + n], th = dt * args.in[pb + 2][g * NS + n];
            const float m32 = expf(32.f * lnm); const float ar = m32 * cosf(32.f * th), ai = m32 * sinf(32.f * th);
            const float mS = expf(1056.f * lnm); const float Ar = mS * cosf(1056.f * th), Ai = mS * sinf(1056.f * th);
            float er[33], ei[33];
            const float* sbase = SEND + (size_t)g * NCR * 256 + d * 128 + n;
#pragma unroll
            for (int k = 0; k < 33; ++k) { const int pos = wave * 33 + k; const int crow = (pos < 8) ? 1024 + 8 * b + (d ? 7 - pos : pos) : 256 * b + (d ? 255 - (pos - 8) : (pos - 8));
                er[k] = __builtin_nontemporal_load(sbase + (size_t)crow * 256); ei[k] = __builtin_nontemporal_load(sbase + (size_t)crow * 256 + 64); }
            float sr = 0.f, si = 0.f;
#pragma unroll
            for (int k = 0; k < 33; ++k) { const float nr = ar * sr - ai * si + er[k], ni = ar * si + ai * sr + ei[k]; sr = nr; si = ni; }
            seg[(wave * 64 + n) * 2] = sr; seg[(wave * 64 + n) * 2 + 1] = si;
            __syncthreads();
            sr = 0.f; si = 0.f;
            for (int w = 0; w < wave; ++w) { const float tr = seg[(w * 64 + n) * 2], ti = seg[(w * 64 + n) * 2 + 1]; const float nr = Ar * sr - Ai * si + tr, ni = Ar * si + Ai * sr + ti; sr = nr; si = ni; }
            bf16* ubase = UG + (size_t)g * NCR * UGK + 512 + d * 128 + n;
#pragma unroll
            for (int k = 0; k < 33; ++k) { const int pos = wave * 33 + k;
                if (pos >= 8) { const int crow = 256 * b + (d ? 255 - (pos - 8) : (pos - 8)); ubase[(size_t)crow * UGK] = f2bf(sr); ubase[(size_t)crow * UGK + 64] = f2bf(si); }
                const float nr = ar * sr - ai * si + er[k], ni = ar * si + ai * sr + ei[k]; sr = nr; si = ni; }
            __syncthreads();
        }
        }
        if (BOTH(4)) { xcd_barrier(bar); if (DUPBAR) xcd_barrier(bar); }
    }
    if (IN(5)) {
        for (int rep_ = 0; rep_ < ((DUPMASK >> 5) & 1) + 1; ++rep_) {
        SchedY S{(const char*)UG, (const char*)Tm, G, bx}; EpiY E{YA};
        gemm_phase<EpiY, SchedY, false>(lds, UGK, UGK * 2, UGK * 2, S, E);
        }
        if (BOTH(5)) { xcd_barrier(bar); if (DUPBAR) xcd_barrier(bar); }
    }

    if (IN(6)) {
        for (int rep_ = 0; rep_ < ((DUPMASK >> 6) & 1) + 1; ++rep_) {
        SchedGluPair S{(const char*)YA, (const char*)Wglu_t, G, bx, (SDUP >> 6) & 1}; MEpiGlu E{TMP, SA};
        gemm_phase<MEpiGlu, SchedGluPair, false>(lds, 512, 1024u, 1024u, S, E);
        }
        if (BOTH(6)) { __builtin_amdgcn_fence(__ATOMIC_ACQUIRE, "agent"); asm volatile("s_waitcnt vmcnt(0)" ::: "memory"); __syncthreads(); }
    }
    if (IN(7)) {
        for (int rep_ = 0; rep_ < ((DUPMASK >> 7) & 1) + 1; ++rep_) {
        SchedGrid S{(const char*)A2, (const char*)Wcv_t, G, bx, 128, 4, 1024u, 1024u, (SDUP >> 7) & 1}; MEpiCv E{MG, TMP, SB};
        gemm_phase<MEpiCv, SchedGrid, false>(lds, 512, 1024u, 1024u, S, E);
        }
        if (BOTH(7)) { xcd_barrier(bar); if (DUPBAR) xcd_barrier(bar); }
    }
    if (IN(8)) {
        for (int rep_ = 0; rep_ < ((DUPMASK >> 8) & 1) + 1; ++rep_) {
        SchedGrid S{(const char*)MG, (const char*)Wo_t, G, bx, 128, 4, 2048u, 2048u, (SDUP >> 8) & 1}; MEpiWo E{MIXG, MODF};
        gemm_phase<MEpiWo, SchedGrid, false>(lds, D, 2048u, 2048u, S, E);
        }
        if (BOTH(8)) { xcd_barrier(bar); if (DUPBAR) xcd_barrier(bar); }
    }
    if (IN(9)) {
        for (int rep_ = 0; rep_ < ((DUPMASK >> 9) & 1) + 1; ++rep_) {
        LAS float* pl = (LAS float*)lds;
        const int bat = bx / (G / 4);
        for (int i = tid; i < 4096; i += NTHR) { const int w = i >> 10, c = i & 1023; pl[i] = (w == 0) ? args.in[27][c] : (w == 1) ? args.in[28][c] : (w == 2) ? MODF[bat * 6144 + 3072 + c] : MODF[bat * 6144 + 4096 + c]; }
        LAS unsigned* wrl = (LAS unsigned*)(lds + 16384);
        LAS float* sl = (LAS float*)(lds + 16384 + 74304);
        LAS int* el = (LAS int*)(lds + 16384 + 74304 + 18944);
        for (int i = tid; i < 4608; i += NTHR) { const int n = i >> 7, c = i & 127; *(LAS u32x4*)(wrl + n * 516 + c * 4) = *(const u32x4*)((const unsigned*)Wr_t + i * 4); }
        __syncthreads();
        const int rows_per_blk = T / G;
        for (int it = 0; it < rows_per_blk / (2 * NWAVES); ++it) {
            f32x4 v[2][4], pe[2][4]; u32x2 mx[2][4];
#pragma unroll
            for (int h = 0; h < 2; ++h) { const int r = bx * rows_per_blk + wave + 16 * it + 8 * h; const int l = r & (L - 1); const float* pr = POSR + (l >> 6) * 512; const float* pc = POSC + (l & 63) * 512;
#pragma unroll
                for (int j = 0; j < 4; ++j) { const int d0 = 256 * j + 4 * lane; v[h][j] = ldnt4(args.in[0] + (size_t)r * D + d0); mx[h][j] = ldnt2u(MIXG + (size_t)r * D + d0);
                    pe[h][j] = (j < 2) ? *(const f32x4*)(pr + d0) : *(const f32x4*)(pc + d0 - 512); } }
            __builtin_amdgcn_sched_barrier(0);
#pragma unroll
            for (int h = 0; h < 2; ++h) { const int r = bx * rows_per_blk + wave + 16 * it + 8 * h; float s = 0.f;
#pragma unroll
                for (int j = 0; j < 4; ++j) { f32x4 mo; mo[0] = blo(mx[h][j].x); mo[1] = bhi(mx[h][j].x); mo[2] = blo(mx[h][j].y); mo[3] = bhi(mx[h][j].y);
                    v[h][j] = (v[h][j] + pe[h][j]) * ALPHA + mo; s += (v[h][j][0] + v[h][j][1]) + (v[h][j][2] + v[h][j][3]); }
                float mean = wsum(s) * (1.f / D), s2 = 0.f;
#pragma unroll
                for (int j = 0; j < 4; ++j) { v[h][j] = v[h][j] - mean; s2 += (v[h][j][0] * v[h][j][0] + v[h][j][1] * v[h][j][1]) + (v[h][j][2] * v[h][j][2] + v[h][j][3] * v[h][j][3]); }
                float rstd = rsqrtf(wsum(s2) * (1.f / D) + LN_EPS); s = 0.f;
#pragma unroll
                for (int j = 0; j < 4; ++j) { const int d0 = 256 * j + 4 * lane; v[h][j] = v[h][j] * rstd * *(const LAS f32x4*)(pl + d0) + *(const LAS f32x4*)(pl + 1024 + d0);
                    u32x2 w; w.x = cvt_pk_bf16(v[h][j][0], v[h][j][1]); w.y = cvt_pk_bf16(v[h][j][2], v[h][j][3]); __builtin_nontemporal_store(w, (u32x2*)(X1B + (size_t)r * D + d0));
                    s += (v[h][j][0] + v[h][j][1]) + (v[h][j][2] + v[h][j][3]); }
                mean = wsum(s) * (1.f / D); s2 = 0.f;
#pragma unroll
                for (int j = 0; j < 4; ++j) { v[h][j] = v[h][j] - mean; s2 += (v[h][j][0] * v[h][j][0] + v[h][j][1] * v[h][j][1]) + (v[h][j][2] * v[h][j][2] + v[h][j][3] * v[h][j][3]); }
                rstd = rsqrtf(wsum(s2) * (1.f / D) + LN_EPS);
#pragma unroll
                for (int j = 0; j < 4; ++j) { const int d0 = 256 * j + 4 * lane; const f32x4 o = v[h][j] * rstd * (*(const LAS f32x4*)(pl + 3072 + d0) + 1.0f) + *(const LAS f32x4*)(pl + 2048 + d0);
                    u32x2 w; w.x = cvt_pk_bf16(o[0], o[1]); w.y = cvt_pk_bf16(o[2], o[3]); *(u32x2*)(H2 + (size_t)r * D + d0) = w; } }
        }
        asm volatile("s_waitcnt vmcnt(0)" ::: "memory");
        __syncthreads();
        {
            const int m = lane & 15, q = lane >> 4; const bf16* arow = H2 + (size_t)(bx * rows_per_blk + 16 * wave + m) * D + 8 * q;
            f32x4 lacc[3];
#pragma unroll
            for (int t = 0; t < 3; ++t) lacc[t] = (f32x4){0.f, 0.f, 0.f, 0.f};
            const LAS unsigned* brow[3];
#pragma unroll
            for (int t = 0; t < 3; ++t) { const int n = 16 * t + m; brow[t] = wrl + (n < 36 ? n : 35) * 516 + 4 * q; }
#pragma unroll 4
            for (int c = 0; c < 32; ++c) { const bf16x8 af = *(const bf16x8*)(arow + 32 * c);
#pragma unroll
                for (int t = 0; t < 3; ++t) { const bf16x8 bf = *(const LAS bf16x8*)(brow[t] + 16 * c); lacc[t] = __builtin_amdgcn_mfma_f32_16x16x32_bf16(af, bf, lacc[t], 0, 0, 0); } }
#pragma unroll
            for (int t = 0; t < 3; ++t) { const int n = 16 * t + m; if (n < 36) { const float bsv = (n < 4) ? args.in[30][n] : args.in[32][n - 4];
#pragma unroll
                for (int i = 0; i < 4; ++i) sl[(16 * wave + 4 * q + i) * 37 + n] = lacc[t][i] + bsv; } }
        }
        __syncthreads();
        {
            const int tpb = T / G;
            if (tid < tpb) { const LAS float* gl = sl + tid * 37; const int t = bx * tpb + tid;
                int gi = 0; float gm = gl[0];
                for (int j = 1; j < 4; ++j) { if (gl[j] > gm) { gm = gl[j]; gi = j; } }
                float gs = 0.f; for (int j = 0; j < 4; ++j) gs += __expf(gl[j] - gm);
                const float pg = 1.f / gs; const LAS float* ee = gl + 4 + gi * 8;
                int i1 = 0; for (int j = 1; j < 8; ++j) if (ee[j] > ee[i1]) i1 = j;
                int i2 = (i1 == 0) ? 1 : 0; for (int j = 0; j < 8; ++j) if (j != i1 && ee[j] > ee[i2]) i2 = j;
                const float e2 = __expf(ee[i2] - ee[i1]); const float w1 = pg / (1.f + e2), w2 = pg * e2 / (1.f + e2);
                eidx[2 * t] = gi * 8 + i1; eidx[2 * t + 1] = gi * 8 + i2; wgt[2 * t] = w1; wgt[2 * t + 1] = w2;
                el[2 * tid] = gi * 8 + i1; el[2 * tid + 1] = gi * 8 + i2; }
            __syncthreads();
            if (tid < 2 * tpb) { const int e = el[tid]; int rk = 0; for (int a_ = 0; a_ < tid; ++a_) rk += (el[a_] == e) ? 1 : 0; rankl[bx * 2 * tpb + tid] = rk; }
            if (tid >= 2 * tpb && tid < 2 * tpb + 32) { const int e = tid - 2 * tpb; int cn = 0; for (int a_ = 0; a_ < 2 * tpb; ++a_) cn += (el[a_] == e) ? 1 : 0; hist[bx * 32 + e] = cn; }
        }
        __syncthreads();
        }
        if (BOTH(9)) { xcd_barrier(bar); if (DUPBAR) xcd_barrier(bar); }
    }
    if (IN(12)) {
        for (int rep_ = 0; rep_ < ((DUPMASK >> 12) & 1) + 1; ++rep_) {
        LAS int* tot = (LAS int*)lds; LAS int* pre = tot + 32; LAS int* off = tot + 64;
        const int tpb = T / G;
        if (tid < 32) { int tt = 0, pp = 0; for (int b = 0; b < G; ++b) { const int h = hist[b * 32 + tid]; tt += h; pp += (b < bx) ? h : 0; } tot[tid] = tt; pre[tid] = pp; }
        __syncthreads();
        if (tid == 0) { int o = 0; for (int e = 0; e < 32; ++e) { off[e] = o; o += (tot[e] + 255) & ~255; } off[32] = o; }
        __syncthreads();
        if (tid < 2 * tpb) { const int a = bx * 2 * tpb + tid; const int e = eidx[a]; const int slot = off[e] + pre[e] + rankl[a]; tokl[slot] = a >> 1; asgl[slot] = a; wsl[slot] = wgt[a]; }
        if (bx < 32) { const int e = bx; const int lo_ = off[e] + tot[e], hi_ = off[e + 1]; for (int sl_ = lo_ + tid; sl_ < hi_; sl_ += NTHR) { tokl[sl_] = 0; asgl[sl_] = -1; wsl[sl_] = 0.f; } }
        if (bx == 0 && tid < 33) meta[tid] = off[tid];
        __syncthreads();
        }
        if (BOTH(12)) { xcd_barrier(bar); if (DUPBAR) xcd_barrier(bar); }
    }
    if (IN(13)) {
        for (int rep_ = 0; rep_ < ((DUPMASK >> 13) & 1) + 1; ++rep_) {
        SchedExp S{(const char*)H2, (const char*)Wgu_t, tokl, meta, G, bx, 2048u, 2048u, (size_t)D * D * 2, 1, (SDUP >> 13) & 1}; MEpiHid E{HID};
        gemm_phase<MEpiHid, SchedExp, true>(lds, D, 2048u, 2048u, S, E);
        }
        if (BOTH(13)) { xcd_barrier(bar); if (DUPBAR) xcd_barrier(bar); }
    }
    if (IN(14)) {
        for (int rep_ = 0; rep_ < ((DUPMASK >> 14) & 1) + 1; ++rep_) {
        SchedExp S{(const char*)HID, (const char*)Wd_t, tokl, meta, G, bx, 1024u, 1024u, (size_t)D * FF * 2, 0, (SDUP >> 14) & 1}; MEpiDown E{Y2, asgl, wsl};
        gemm_phase<MEpiDown, SchedExp, false>(lds, FF, 1024u, 1024u, S, E);
        }
        if (BOTH(14)) { xcd_barrier(bar); if (DUPBAR) xcd_barrier(bar); }
    }
    if (IN(15)) {
        LAS float* pl = (LAS float*)lds;
        const int bat = bx / (G / 4);
        for (int i = tid; i < 3072; i += NTHR) { const int w = i >> 10, c = i & 1023; pl[i] = (w == 0) ? args.in[36][c] : (w == 1) ? args.in[37][c] : MODF[bat * 6144 + 5120 + c]; }
        __syncthreads();
        const int rows_per_blk = T / G;
        for (int it = 0; it < rows_per_blk / (2 * NWAVES); ++it) {
            u32x2 xb[2][4], y0[2][4], y1[2][4];
#pragma unroll
            for (int h = 0; h < 2; ++h) { const int r = bx * rows_per_blk + wave + 16 * it + 8 * h;
#pragma unroll
                for (int j = 0; j < 4; ++j) { const int d0 = 256 * j + 4 * lane; xb[h][j] = ldnt2u(X1B + (size_t)r * D + d0);
                    y0[h][j] = ldnt2u(Y2 + (size_t)(2 * r) * D + d0); y1[h][j] = ldnt2u(Y2 + (size_t)(2 * r + 1) * D + d0); } }
            __builtin_amdgcn_sched_barrier(0);
#pragma unroll
            for (int h = 0; h < 2; ++h) { const int r = bx * rows_per_blk + wave + 16 * it + 8 * h; float* orow = args.out + (size_t)r * D; f32x4 v[4]; float s = 0.f;
#pragma unroll
                for (int j = 0; j < 4; ++j) { const int d0 = 256 * j + 4 * lane; const f32x4 g2 = *(const LAS f32x4*)(pl + 2048 + d0);
                    f32x4 x1, mo; x1[0] = blo(xb[h][j].x); x1[1] = bhi(xb[h][j].x); x1[2] = blo(xb[h][j].y); x1[3] = bhi(xb[h][j].y);
                    mo[0] = blo(y0[h][j].x) + blo(y1[h][j].x); mo[1] = bhi(y0[h][j].x) + bhi(y1[h][j].x); mo[2] = blo(y0[h][j].y) + blo(y1[h][j].y); mo[3] = bhi(y0[h][j].y) + bhi(y1[h][j].y);
                    v[j] = x1 * ALPHA + g2 * mo; s += (v[j][0] + v[j][1]) + (v[j][2] + v[j][3]); }
                const float mean = wsum(s) * (1.f / D); float s2 = 0.f;
#pragma unroll
                for (int j = 0; j < 4; ++j) { v[j] = v[j] - mean; s2 += (v[j][0] * v[j][0] + v[j][1] * v[j][1]) + (v[j][2] * v[j][2] + v[j][3] * v[j][3]); }
                const float rstd = rsqrtf(wsum(s2) * (1.f / D) + LN_EPS);
#pragma unroll
                for (int j = 0; j < 4; ++j) { const int d0 = 256 * j + 4 * lane; __builtin_nontemporal_store(v[j] * rstd * *(const LAS f32x4*)(pl + d0) + *(const LAS f32x4*)(pl + 1024 + d0), (f32x4*)(orow + d0)); } }
        }
    }
#undef IN
#undef BOTH
}
}

extern "C" void kernel_launch(void* const* d_in, const int* in_sizes, int n_in, void* d_out, int out_size, void* d_ws, size_t ws_size, hipStream_t stream) {
    if (ws_size < WS_END + 64 * MiB) { fprintf(stderr, "workspace too small: %zu < %zu\n", ws_size, (size_t)WS_END); return; }
    auto F = [&](int i) { return (const float*)d_in[i]; };
    char* ws = (char*)d_ws; float* out = (float*)d_out;
    float* mod = (float*)(ws + WS_MOD);
    char* rt = ws + WS_ROUT; int* eidx = (int*)(rt + RT_EIDX); float* wgt = (float*)(rt + RT_WGT); int* tok = (int*)(rt + RT_TOK); int* asg = (int*)(rt + RT_ASG); int* cnt = (int*)(rt + RT_CNT);
    bf16* XN = (bf16*)(ws + WS_RA); float* YF = (float*)(ws + WS_RA); bf16* TMP = (bf16*)(ws + WS_RA); bf16* H2 = (bf16*)(ws + WS_RA);
    bf16* UG = (bf16*)(ws + WS_RB); bf16* MG = (bf16*)(ws + WS_RB); bf16* HID = (bf16*)(ws + WS_RB);
    bf16* WC = (bf16*)(ws + WS_RD); bf16* YA = WC; bf16* GB = (bf16*)(ws + WS_RD + 32 * MiB); bf16* A2 = (bf16*)(ws + WS_RD + 64 * MiB); bf16* Y2 = (bf16*)(ws + WS_RD);
    bf16* SA = (bf16*)d_out; bf16* SB = SA + (size_t)T * D;
    const float* w_in = F(6);

    static int grid = 0;
    if (grid == 0) {
        int dev = 0, cus = 0, per_cu = 0;
        if (hipGetDevice(&dev) != hipSuccess || hipDeviceGetAttribute(&cus, hipDeviceAttributeMultiprocessorCount, dev) != hipSuccess) { fprintf(stderr, "device query failed\n"); grid = -1; return; }
        if (hipOccupancyMaxActiveBlocksPerMultiprocessor(&per_cu, (const void*)fwd, NTHR, 0) != hipSuccess || per_cu < 1) fprintf(stderr, "occupancy query says %d\n", per_cu);
        (void)hipGetLastError();
        grid = cus;
        if (grid != 256) fprintf(stderr, "warning: grid %d != 256\n", grid);
    }
    if (grid < 0) return;
    (void)hipMemsetAsync(ws + WS_CTL, 0, 1 * MiB, stream);
    Args a{};
    for (int i = 0; i < 38; ++i) a.in[i] = (const float*)d_in[i];
    a.out = out; a.ws = (unsigned char*)d_ws; a.pad = 0;
    auto run = [&](int lo, int hi, int li) { a.ph_lo = lo; a.ph_hi = hi; a.li = li; hipLaunchKernelGGL(fwd, dim3(grid), dim3(NTHR), 0, stream, a); };
#ifndef USE_P1
#define USE_P1 0
#endif
#ifndef USE_P2
#define USE_P2 0
#endif
    run(0, 16, 0);
}
```

```cpp
#include <hip/hip_runtime.h>
#include <math.h>
#include <stdio.h>

#ifndef SIMPLE_RED
#define SIMPLE_RED 0
#endif
#ifndef DOT2_BUILTIN
#define DOT2_BUILTIN 1
#endif
#ifndef DUPMASK
#define DUPMASK 0
#endif
#ifndef NOEPI_DUP
#define NOEPI_DUP 0
#endif
#ifndef DUPEPI
#define DUPEPI 0
#endif
#ifndef SDUP
#define SDUP 0
#endif
#ifndef DUPBAR
#define DUPBAR 0
#endif
namespace {
typedef unsigned short bf16;
constexpr int D = 1024, NBATCH = 4, L = 8192, T = NBATCH * L, CTXL = 256, TC = NBATCH * CTXL, TALL = T + TC;
constexpr int NG = 32, NS = 64, NE = 32, FF = 512, INW = 4096;
constexpr int QC = 32;
constexpr int NCR = 1280;
constexpr int UGK = 768;
constexpr int NSLOT = 2 * T + NE * 256;
constexpr float ALPHA = 1.189207115002721f, LN_EPS = 1e-6f;

constexpr size_t MiB = 1u << 20;
constexpr size_t WS_CTL = 0;
constexpr size_t WS_MOD = 1 * MiB;
constexpr size_t WS_POS = 2 * MiB;
constexpr size_t WS_ROUT = 3 * MiB;
constexpr size_t RT_EIDX = 0, RT_WGT = 256 * 1024, RT_TOK = 512 * 1024, RT_ASG = 1024 * 1024, RT_CNT = 1536 * 1024;
constexpr size_t RT_HIST = 1600 * 1024, RT_RANK = 1664 * 1024, RT_META = 1920 * 1024;
constexpr size_t WS_LOGIT = 6 * MiB;
constexpr size_t WS_WIN = 14 * MiB, WS_WGLU = 22 * MiB, WS_WCV = 24 * MiB, WS_WO = 25 * MiB, WS_WR = 27 * MiB, WS_PM = 28 * MiB, WS_TM = 36 * MiB, WS_WGU = 60 * MiB, WS_WD = 124 * MiB;
constexpr size_t WS_RA = 156 * MiB;
constexpr size_t WS_RB = 222 * MiB;
constexpr size_t WS_RD = 294 * MiB;
constexpr size_t WS_END = 422 * MiB;

__device__ __forceinline__ float bf2f(bf16 h) { return __uint_as_float(((unsigned)h) << 16); }
__device__ __forceinline__ bf16 f2bf(float f) { unsigned u = __float_as_uint(f); u += 0x7fffu + ((u >> 16) & 1u); return (bf16)(u >> 16); }
__device__ __forceinline__ float sigmoidf_(float x) { return 1.f / (1.f + expf(-x)); }
__device__ __forceinline__ float siluf_(float x) { return x / (1.f + expf(-x)); }
__device__ __forceinline__ float geluf_(float x) { return 0.5f * x * (1.f + tanhf(0.7978845608028654f * (x + 0.044715f * x * x * x))); }
__device__ __forceinline__ float wave_sum(float v) {
#pragma unroll
    for (int o = 32; o >= 1; o >>= 1) v += __shfl_xor(v, o);
    return v;
}
__device__ __forceinline__ float pos_emb(int l, int d) {
    const int row = l >> 6, col = l & 63; const int q = d >> 8, i = d & 255;
    const float omega = 1.0f / powf(10000.0f, (float)i / 256.0f);
    const float p = (q < 2) ? (float)row : (float)col; const float a = p * omega;
    return (q & 1) ? cosf(a) : sinf(a);
}
__device__ __forceinline__ size_t ug_index(int r, int c) { return ((size_t)(c >> 4) * NCR + (r >> 5)) * UGK + (r & 31) * 16 + (c & 15); }

__global__ __launch_bounds__(256) void k_mod(const float* c, const float* c_ctx, const float* w_ada, const float* b_ada, float* mod) {
    __shared__ float sc[5][1024];
    for (int i = threadIdx.x; i < 5 * 1024; i += blockDim.x) { const int v = i >> 10, k = i & 1023; const float x = v < 4 ? c[v * 1024 + k] : c_ctx[k]; sc[v][k] = siluf_(x); }
    __syncthreads();
    const int col = blockIdx.x * blockDim.x + threadIdx.x;
    float acc[5] = {0, 0, 0, 0, 0};
    for (int k = 0; k < 1024; ++k) { const float w = w_ada[(size_t)k * 6144 + col];
#pragma unroll
        for (int v = 0; v < 5; ++v) acc[v] += sc[v][k] * w; }
    const float bb = b_ada[col];
#pragma unroll
    for (int v = 0; v < 5; ++v) mod[v * 6144 + col] = acc[v] + bb;
}

__global__ __launch_bounds__(256) void k_lnmod(const float* x, const float* ctx, const float* mod, bf16* XN) {
    const int r = blockIdx.x * 4 + (threadIdx.x >> 6), lane = threadIdx.x & 63;
    float v[16]; float s = 0.f; int mv;
    if (r < T) { const int l = r & (L - 1); mv = r / L;
#pragma unroll
        for (int i = 0; i < 16; ++i) { const int d = lane + 64 * i; v[i] = x[(size_t)r * D + d] + pos_emb(l, d); s += v[i]; } }
    else { mv = 4;
#pragma unroll
        for (int i = 0; i < 16; ++i) { const int d = lane + 64 * i; v[i] = ctx[(size_t)(r - T) * D + d]; s += v[i]; } }
    const float mu = wave_sum(s) * (1.f / D); float q = 0.f;
#pragma unroll
    for (int i = 0; i < 16; ++i) { v[i] -= mu; q += v[i] * v[i]; }
    const float rstd = rsqrtf(wave_sum(q) * (1.f / D) + LN_EPS);
    const float* sh = mod + mv * 6144; const float* sc = sh + 1024;
#pragma unroll
    for (int i = 0; i < 16; ++i) { const int d = lane + 64 * i; XN[(size_t)r * D + d] = f2bf(v[i] * rstd * (1.f + sc[d]) + sh[d]); }
}

struct Stream { const bf16* A; const int* ridx; const float* B0; const float* B1; size_t bstride; int lda; int K; int ldb; int pad; };
static Stream mk_stream(const bf16* A, int lda, const int* ridx, int K, const float* B0, const float* B1, int ldb, size_t bstride) {
    Stream s{}; s.A = A; s.ridx = ridx; s.B0 = B0; s.B1 = B1; s.bstride = bstride; s.lda = lda; s.K = K; s.ldb = ldb; s.pad = 0; return s; }
template <int NB>
__device__ __forceinline__ void gemm_accum(float (&acc)[NB][4][4], const Stream& s, size_t boff, int M, int rbase, int m0, int n0, float* As, float* Bs) {
    const int tid = threadIdx.x, tx = tid & 15, ty = tid >> 4;
    const int ar = tid >> 2, ak = (tid & 3) * 4, bk = tid >> 4, bn = (tid & 15) * 4;
    const int grow = m0 + ar; const bool av = grow < M;
    const size_t arow = av ? (s.ridx ? (size_t)s.ridx[rbase + grow] : (size_t)(rbase + grow)) : 0;
    const bf16* ap = s.A + arow * s.lda + ak;
    const float* Bp[2] = {s.B0 + boff, s.B1 ? s.B1 + boff : nullptr};
    for (int k0 = 0; k0 < s.K; k0 += 16) {
        const uint2 a = av ? *(const uint2*)(ap + k0) : make_uint2(0u, 0u);
        As[(ak + 0) * 68 + ar] = __uint_as_float(a.x << 16); As[(ak + 1) * 68 + ar] = __uint_as_float(a.x & 0xffff0000u);
        As[(ak + 2) * 68 + ar] = __uint_as_float(a.y << 16); As[(ak + 3) * 68 + ar] = __uint_as_float(a.y & 0xffff0000u);
#pragma unroll
        for (int j = 0; j < NB; ++j) *(float4*)&Bs[(j * 16 + bk) * 64 + bn] = *(const float4*)(Bp[j] + (size_t)(k0 + bk) * s.ldb + n0 + bn);
        __syncthreads();
#pragma unroll
        for (int kk = 0; kk < 16; ++kk) { const float4 a4 = *(const float4*)&As[kk * 68 + ty * 4]; const float aa[4] = {a4.x, a4.y, a4.z, a4.w};
#pragma unroll
            for (int j = 0; j < NB; ++j) { const float4 b4 = *(const float4*)&Bs[(j * 16 + kk) * 64 + tx * 4]; const float bb[4] = {b4.x, b4.y, b4.z, b4.w};
#pragma unroll
                for (int i = 0; i < 4; ++i)
#pragma unroll
                    for (int jj = 0; jj < 4; ++jj) acc[j][i][jj] += aa[i] * bb[jj]; } }
        __syncthreads();
    }
}
template <int NB, class Epi>
__global__ __launch_bounds__(256) void k_gemm(Stream s0, long long M, const int* seg, Epi epi) {
    __shared__ float As[16 * 68]; __shared__ float Bs[2 * 16 * 64];
    int rbase = 0, Ml = (int)M; size_t e = 0;
    if (seg) { e = blockIdx.z; rbase = seg[64 + e]; Ml = seg[e]; }
    const int m0 = blockIdx.y * 64, n0 = blockIdx.x * 64;
    if (m0 >= Ml) return;
    float acc0[NB][4][4] = {};
    gemm_accum<NB>(acc0, s0, e * s0.bstride, Ml, rbase, m0, n0, As, Bs);
    const int tx = threadIdx.x & 15, ty = threadIdx.x >> 4;
#pragma unroll
    for (int i = 0; i < 4; ++i) { const int r = m0 + ty * 4 + i; if (r >= Ml) continue;
#pragma unroll
        for (int j = 0; j < 4; ++j) { float a[2] = {0.f, 0.f};
#pragma unroll
            for (int b = 0; b < NB; ++b) a[b] = acc0[b][i][j];
            epi(rbase + r, n0 + tx * 4 + j, a); } }
}
struct EpiUG { bf16* UG; __device__ void operator()(int r, int c, const float* a) const { UG[ug_index(r, c)] = f2bf(a[0]); } };
struct EpiWc { bf16* WC; __device__ void operator()(int r, int c, const float* a) const { WC[(size_t)r * 512 + c] = f2bf(a[0] * a[1]); } };
struct EpiBf { bf16* O; int ldc; int pad; __device__ void operator()(int r, int c, const float* a) const { O[(size_t)r * ldc + c] = f2bf(a[0]); } };
struct EpiSig { bf16* SA; bf16* SB; __device__ void operator()(int r, int c, const float* a) const { const bf16 v = f2bf(sigmoidf_(a[0])); if (c < D) SA[(size_t)r * D + c] = v; else SB[(size_t)r * D + c - D] = v; } };
struct EpiGlu { bf16* TMP; const bf16* SA; __device__ void operator()(int r, int c, const float* a) const { TMP[(size_t)r * D + c] = f2bf(a[0] * sigmoidf_(a[1]) * bf2f(SA[(size_t)r * D + c])); } };
struct EpiCv { bf16* MG; const bf16* TMP; const bf16* SB; __device__ void operator()(int r, int c, const float* a) const { const size_t i = (size_t)r * D + c; MG[i] = f2bf(bf2f(TMP[i]) + bf2f(SB[i]) * a[0]); } };
struct EpiWo { float* Y1; const float* x; const float* mod; __device__ void operator()(int r, int c, const float* a) const { const size_t i = (size_t)r * D + c;
    Y1[i] = ALPHA * (x[i] + pos_emb(r & (L - 1), c)) + mod[(r / L) * 6144 + 2048 + c] * a[0]; } };
struct EpiHid { bf16* HID; __device__ void operator()(int r, int c, const float* a) const { HID[(size_t)r * FF + c] = f2bf(siluf_(a[0]) * a[1]); } };
struct EpiDown { bf16* Y2; const int* asg; const float* wgt; __device__ void operator()(int r, int c, const float* a) const { const int as = asg[r]; if (as >= 0) Y2[(size_t)as * D + c] = f2bf(wgt[as] * a[0]); } };

struct S5P { const float *log_dt, *a_re, *a_im, *b_re, *b_im, *c_re, *c_im; };
__global__ __launch_bounds__(64) void k_s5(S5P pf, S5P pb, const float* s5d, const bf16* UG, float* YF, bf16* YA) {
    const int b = blockIdx.x >> 5, g = blockIdx.x & 31, n = threadIdx.x;
    for (int dir = 0; dir < 2; ++dir) {
        const S5P& p = dir ? pb : pf;
        const float dt = expf(p.log_dt[g]); const float are = p.a_re[g * NS + n], aim = p.a_im[g * NS + n];
        const float mag = expf(dt * are); const float abr = mag * cosf(dt * aim), abi = mag * sinf(dt * aim);
        const float den = are * are + aim * aim, xr = abr - 1.f;
        const float fr = (xr * are + abi * aim) / den, fi = (abi * are - xr * aim) / den;
        float bbr[16], bbi[16], cr[16], ci[16];
#pragma unroll
        for (int c = 0; c < 16; ++c) { const float br = p.b_re[(g * NS + n) * 16 + c], bi = p.b_im[(g * NS + n) * 16 + c];
            bbr[c] = fr * br - fi * bi; bbi[c] = fr * bi + fi * br;
            cr[c] = p.c_re[(g * 16 + c) * NS + n]; ci[c] = p.c_im[(g * 16 + c) * NS + n]; }
        float sr = 0.f, si = 0.f;
        const float dd = n < 16 ? s5d[g * 16 + n] : 0.f;
        for (int i = 0; i < CTXL + L; ++i) {
            int r; if (i < CTXL) r = T + b * CTXL + (dir ? CTXL - 1 - i : i); else r = b * L + (dir ? L - 1 - (i - CTXL) : (i - CTXL));
            const bf16* u = UG + ug_index(r, g * 16);
            float br = 0.f, bi = 0.f;
#pragma unroll
            for (int c = 0; c < 16; ++c) { const float uu = bf2f(u[c]); br += bbr[c] * uu; bi += bbi[c] * uu; }
            const float nr = abr * sr - abi * si + br, ni = abr * si + abi * sr + bi; sr = nr; si = ni;
            if (i >= CTXL) {
                float mine = 0.f;
#pragma unroll
                for (int c = 0; c < 16; ++c) { const float v = wave_sum(cr[c] * sr - ci[c] * si); mine = (n == c) ? v : mine; }
                if (n < 16) { const size_t yi = (size_t)r * 512 + g * 16 + n;
                    if (dir == 0) YF[yi] = mine; else YA[yi] = f2bf(geluf_(YF[yi] + mine + dd * bf2f(u[n]))); } }
        }
    }
}

__global__ void k_conv(const bf16* WC, const bf16* GB, const float* conv_w, bf16* A2) { const size_t i = (size_t)blockIdx.x * blockDim.x + threadIdx.x; const size_t r = i >> 9; const int c = (int)(i & 511);
    const int p = (int)(r & 63);
    const float wm = p > 0 ? bf2f(WC[i - 512]) : 0.f, w0 = bf2f(WC[i]), wp = p < 63 ? bf2f(WC[i + 512]) : 0.f;
    A2[i] = f2bf(bf2f(GB[i]) * (conv_w[c] * wm + conv_w[512 + c] * w0 + conv_w[1024 + c] * wp)); }

__global__ __launch_bounds__(256) void k_lnmid(const float* mod, const float* g, const float* bta, float* Y1, bf16* H2) {
    const int r = blockIdx.x * 4 + (threadIdx.x >> 6), lane = threadIdx.x & 63; const int b = r / L;
    const float* md = mod + b * 6144; float v[16]; float s = 0.f;
#pragma unroll
    for (int i = 0; i < 16; ++i) { const int d = lane + 64 * i; v[i] = Y1[(size_t)r * D + d]; s += v[i]; }
    float mu = wave_sum(s) * (1.f / D), q = 0.f;
#pragma unroll
    for (int i = 0; i < 16; ++i) { v[i] -= mu; q += v[i] * v[i]; }
    float rstd = rsqrtf(wave_sum(q) * (1.f / D) + LN_EPS); s = 0.f;
#pragma unroll
    for (int i = 0; i < 16; ++i) { const int d = lane + 64 * i; v[i] = v[i] * rstd * g[d] + bta[d]; Y1[(size_t)r * D + d] = v[i]; s += v[i]; }
    mu = wave_sum(s) * (1.f / D); q = 0.f;
#pragma unroll
    for (int i = 0; i < 16; ++i) { v[i] -= mu; q += v[i] * v[i]; }
    rstd = rsqrtf(wave_sum(q) * (1.f / D) + LN_EPS);
#pragma unroll
    for (int i = 0; i < 16; ++i) { const int d = lane + 64 * i; H2[(size_t)r * D + d] = f2bf(v[i] * rstd * (1.f + md[4096 + d]) + md[3072 + d]); }
}

__global__ __launch_bounds__(256) void k_router(const bf16* H2, const float* Wg, const float* bg, const float* We, const float* be, int* eidx, float* wgt, int* counts) {
    const int t = blockIdx.x * 4 + (threadIdx.x >> 6), lane = threadIdx.x & 63;
    float lg[36];
#pragma unroll
    for (int j = 0; j < 36; ++j) lg[j] = 0.f;
    for (int i = 0; i < 16; ++i) { const int k = lane + 64 * i; const float h = bf2f(H2[(size_t)t * D + k]);
#pragma unroll
        for (int j = 0; j < 4; ++j) lg[j] += h * Wg[k * 4 + j];
#pragma unroll
        for (int j = 0; j < 32; ++j) lg[4 + j] += h * We[k * 32 + j]; }
    __shared__ float sl[4][40];
    float mine = 0.f;
#pragma unroll
    for (int j = 0; j < 36; ++j) { const float v = wave_sum(lg[j]); mine = (lane == j) ? v : mine; }
    if (lane < 4) mine += bg[lane]; else if (lane < 36) mine += be[lane - 4];
    if (lane < 36) sl[threadIdx.x >> 6][lane] = mine;
    __syncthreads();
    if (lane == 0) {
        const float* gl = sl[threadIdx.x >> 6];
        int gi = 0; float gm = gl[0];
        for (int j = 1; j < 4; ++j) { if (gl[j] > gm) { gm = gl[j]; gi = j; } }
        float gs = 0.f; for (int j = 0; j < 4; ++j) gs += expf(gl[j] - gm);
        const float pg = 1.f / gs;
        const float* el = gl + 4 + gi * 8;
        int i1 = 0; for (int j = 1; j < 8; ++j) if (el[j] > el[i1]) i1 = j;
        int i2 = (i1 == 0) ? 1 : 0; for (int j = 0; j < 8; ++j) if (j != i1 && el[j] > el[i2]) i2 = j;
        const float e2 = expf(el[i2] - el[i1]); const float w1 = pg / (1.f + e2), w2 = pg * e2 / (1.f + e2);
        eidx[2 * t] = gi * 8 + i1; eidx[2 * t + 1] = gi * 8 + i2; wgt[2 * t] = w1; wgt[2 * t + 1] = w2;
        atomicAdd(&counts[gi * 8 + i1], 1); atomicAdd(&counts[gi * 8 + i2], 1);
    }
}
__global__ void k_offsets(int* cnt) { if (threadIdx.x == 0) { int s = 0; for (int e = 0; e < 32; ++e) { cnt[64 + e] = s; s += (cnt[e] + 255) & ~255; cnt[32 + e] = 0; } cnt[96] = s; } }
__global__ void k_scatter(const int* eidx, int* cnt, int* tok, int* asg) { const int a = blockIdx.x * blockDim.x + threadIdx.x; const int e = eidx[a];
    const int p = atomicAdd(&cnt[32 + e], 1); const int s = cnt[64 + e] + p; tok[s] = a >> 1; asg[s] = a; }

__global__ __launch_bounds__(256) void k_final(const bf16* Y2, const float* mod, const float* g, const float* bta, float* out) {
    const int r = blockIdx.x * 4 + (threadIdx.x >> 6), lane = threadIdx.x & 63; const int b = r / L;
    const float* md = mod + b * 6144; float v[16]; float s = 0.f;
#pragma unroll
    for (int i = 0; i < 16; ++i) { const int d = lane + 64 * i; const float m = bf2f(Y2[(size_t)(2 * r) * D + d]) + bf2f(Y2[(size_t)(2 * r + 1) * D + d]);
        v[i] = ALPHA * out[(size_t)r * D + d] + md[5120 + d] * m; s += v[i]; }
    const float mu = wave_sum(s) * (1.f / D); float q = 0.f;
#pragma unroll
    for (int i = 0; i < 16; ++i) { v[i] -= mu; q += v[i] * v[i]; }
    const float rstd = rsqrtf(wave_sum(q) * (1.f / D) + LN_EPS);
#pragma unroll
    for (int i = 0; i < 16; ++i) { const int d = lane + 64 * i; out[(size_t)r * D + d] = v[i] * rstd * g[d] + bta[d]; }
}

#define LAS __attribute__((address_space(3)))
typedef short bf16x8 __attribute__((ext_vector_type(8)));
typedef float f32x4 __attribute__((ext_vector_type(4)));
typedef unsigned u32x4 __attribute__((ext_vector_type(4)));
typedef unsigned u32x2 __attribute__((ext_vector_type(2)));
constexpr int BM = 256, BK = 64, HALF = 128, HTB = HALF * BK * 2, STAGE_BYTES = 8 * HTB, NXCD = 8, WGM = 8;
__device__ __forceinline__ int lds_byte(int r, int c) { const int st = (r >> 4) * 2 + (c >> 5), rr = r & 15, cc = c & 31, ob = rr * 64 + cc * 2; return st * 1024 + (ob ^ (((ob >> 9) & 1) << 5)); }
__device__ __forceinline__ void stage_rc(int b, int& R, int& C) { const int st = b / 1024, sb = b % 1024, swz = sb ^ (((sb >> 9) & 1) << 5); R = (st >> 1) * 16 + swz / 64; C = (st & 1) * 32 + (swz % 64) / 2; }
__device__ __forceinline__ int perm32(int rho) { const int n = rho >> 4, i = rho & 15; return 8 * (i >> 2) + 4 * n + (i & 3); }
typedef float f32x2_t __attribute__((ext_vector_type(2)));
typedef __bf16 bf16x2_t __attribute__((ext_vector_type(2)));
__device__ __forceinline__ unsigned cvt_pk_bf16(float lo, float hi) { f32x2_t v = {lo, hi}; bf16x2_t b = __builtin_convertvector(v, bf16x2_t); return __builtin_bit_cast(unsigned, b); }
__device__ __forceinline__ f32x4 ldnt4(const float* p) { return __builtin_nontemporal_load((const f32x4*)p); }
__device__ __forceinline__ u32x4 ldnt4u(const bf16* p) { return __builtin_nontemporal_load((const u32x4*)p); }
__device__ __forceinline__ u32x2 ldnt2u(const bf16* p) { return __builtin_nontemporal_load((const u32x2*)p); }
__device__ __forceinline__ float fsigmoid(float x) { return __builtin_amdgcn_rcpf(1.f + __expf(-x)); }
__device__ __forceinline__ float blo(unsigned w) { return __uint_as_float(w << 16); }
__device__ __forceinline__ float bhi(unsigned w) { return __uint_as_float(w & 0xffff0000u); }

struct GUnit { const char* A; const char* B; const int* ridx; int pm, pn, aux0, aux1; };
__device__ __forceinline__ bool static_order(int i, int G, int c, int nM, int nN, int& pm, int& pn) {
    const int nwg = nM * nN; const long Lx = (long)i * G + c; if (Lx >= nwg) return false;
    int wgid = (int)Lx; { const int q = nwg / NXCD, r = nwg % NXCD, xcd = wgid % NXCD, off = wgid / NXCD; wgid = (xcd < r ? xcd * (q + 1) : r * (q + 1) + (xcd - r) * q) + off; }
    const int nig = WGM * nN, gid = wgid / nig, fm = gid * WGM, gsz = (nM - fm) < WGM ? (nM - fm) : WGM;
    pm = fm + ((wgid % nig) % gsz); pn = (wgid % nig) / gsz; return true;
}

template <class E_> struct EpiDup { static constexpr bool value = false; };
template <class Epi, class Sched, bool GATHER>
__device__ __forceinline__ void gemm_phase(LAS unsigned char* lds, const int K, const unsigned lda, const unsigned ldb, const Sched& S, const Epi& E) {
    const int tid = threadIdx.x, wid = __builtin_amdgcn_readfirstlane(tid >> 6), lane = tid & 63, wr = wid >> 2, wc = wid & 3, fr = lane & 15, fq = lane >> 4;
    const int nt = K / BK;
    int R0, C0, R1, C1; stage_rc(tid * 16, R0, C0); stage_rc(tid * 16 + 8192, R1, C1);
    const int Rb0 = (R0 & ~31) + perm32(R0 & 31), Rb1 = (R1 & ~31) + perm32(R1 & 31);
    const unsigned vB0 = (unsigned)Rb0 * ldb + C0 * 2, vB1 = (unsigned)Rb1 * ldb + C1 * 2; const size_t hB = (size_t)HALF * ldb;
    const size_t hA = GATHER ? (size_t)0 : (size_t)HALF * lda;
    unsigned vA[2][2], vAn[2][2];
#define PG_SETVA(dst, u) do { if constexpr (GATHER) { const int* _ri = (u).ridx; \
        dst[0][0] = (unsigned)_ri[R0] * lda + C0 * 2; dst[0][1] = (unsigned)_ri[R1] * lda + C1 * 2; dst[1][0] = (unsigned)_ri[128 + R0] * lda + C0 * 2; dst[1][1] = (unsigned)_ri[128 + R1] * lda + C1 * 2; } \
      else { dst[0][0] = (unsigned)R0 * lda + C0 * 2; dst[0][1] = (unsigned)R1 * lda + C1 * 2; dst[1][0] = dst[0][0]; dst[1][1] = dst[0][1]; } } while (0)
    const size_t kstep = (size_t)(BK * 2);
    const unsigned ldsw = (unsigned)wid * 1024u;
    const int aoff = lds_byte(wr * 64 + fr, fq * 8), boff = lds_byte(wc * 32 + fr, fq * 8);
#define PG_SA(b, h) (((b) * 2 + (h)) * HTB)
#define PG_SB(b, h) ((4 + (b) * 2 + (h)) * HTB)
#define PG_STAGE(bufoff, gbase, v0, v1) do { \
        __builtin_amdgcn_global_load_lds((const unsigned*)((const char*)(gbase) + (v0)), (LAS unsigned*)(lds + (bufoff) + ldsw), 16, 0, 0); \
        __builtin_amdgcn_global_load_lds((const unsigned*)((const char*)(gbase) + (v1)), (LAS unsigned*)(lds + (bufoff) + ldsw + 8192), 16, 0, 0); } while (0)
#define PG_LDA(dst, b, h) do { _Pragma("unroll") for (int m = 0; m < 4; ++m) _Pragma("unroll") for (int k = 0; k < 2; ++k) dst[m][k] = *(const LAS bf16x8*)(lds + PG_SA(b, h) + aoff + m * 2048 + k * 1024); } while (0)
#define PG_LDB(dst, b, h) do { _Pragma("unroll") for (int n = 0; n < 2; ++n) _Pragma("unroll") for (int k = 0; k < 2; ++k) dst[n][k] = *(const LAS bf16x8*)(lds + PG_SB(b, h) + boff + n * 2048 + k * 1024); } while (0)
#define PG_MMA(ai, bj, At, Bt) do { __builtin_amdgcn_s_setprio(1); _Pragma("unroll") for (int m = 0; m < 4; ++m) _Pragma("unroll") for (int n = 0; n < 2; ++n) _Pragma("unroll") for (int k = 0; k < 2; ++k) \
        acc[ai][bj][m][n] = __builtin_amdgcn_mfma_f32_16x16x32_bf16(Bt[n][k], At[m][k], acc[ai][bj][m][n], 0, 0, 0); __builtin_amdgcn_s_setprio(0); } while (0)
#define PG_WAIT_V(n) asm volatile("s_waitcnt vmcnt(" #n ")" ::: "memory")
#define PG_WAIT_L(n) asm volatile("s_waitcnt lgkmcnt(" #n ")" ::: "memory")
#define PG_BAR __builtin_amdgcn_s_barrier()
#define PG_SCHED __builtin_amdgcn_sched_barrier(0)
    GUnit cur, nxt; int ui = 0;
    if (!S.next(0, cur)) return;
    PG_SETVA(vA, cur);
    f32x4 acc[2][2][4][2];
#pragma unroll
    for (int a = 0; a < 2; ++a)
#pragma unroll
        for (int b = 0; b < 2; ++b)
#pragma unroll
            for (int m = 0; m < 4; ++m)
#pragma unroll
                for (int n = 0; n < 2; ++n) acc[a][b][m][n] = (f32x4){0.f, 0.f, 0.f, 0.f};
    bf16x8 At[4][2], B0[2][2], B1[2][2];
    const char* cA = cur.A; const char* cB = cur.B;
    PG_STAGE(PG_SB(0, 0), cB, vB0, vB1); PG_STAGE(PG_SB(0, 1), (cB) + hB, vB0, vB1); PG_STAGE(PG_SA(0, 0), cA, vA[0][0], vA[0][1]); PG_STAGE(PG_SA(0, 1), (cA) + hA, vA[1][0], vA[1][1]);
    if (wr == 1) PG_BAR;
    PG_WAIT_V(2); PG_BAR;
    PG_STAGE(PG_SB(1, 0), cB + kstep, vB0, vB1); PG_STAGE(PG_SA(1, 0), cA + kstep, vA[0][0], vA[0][1]); PG_STAGE(PG_SB(1, 1), (cB + kstep) + hB, vB0, vB1);
    PG_WAIT_V(6); PG_BAR;
    for (;;) {
        const bool has_next = S.next(ui + 1, nxt);
        const char* nA = has_next ? nxt.A : cA; const char* nB = has_next ? nxt.B : cB;
        if constexpr (GATHER) { if (has_next) PG_SETVA(vAn, nxt); else { vAn[0][0] = vA[0][0]; vAn[0][1] = vA[0][1]; vAn[1][0] = vA[1][0]; vAn[1][1] = vA[1][1]; } }
        for (int t = 0; t < nt; t += 2) {
            const bool last = (t == nt - 2);
            const char* a1 = cA + (size_t)(t + 1) * kstep;
            const char* a2 = last ? nA : cA + (size_t)(t + 2) * kstep; const char* b2 = last ? nB : cB + (size_t)(t + 2) * kstep;
            const char* a3 = a2 + kstep; const char* b3 = b2 + kstep;
            unsigned w00 = vA[0][0], w01 = vA[0][1], w10 = vA[1][0], w11 = vA[1][1];
            if constexpr (GATHER) { if (last) { w00 = vAn[0][0]; w01 = vAn[0][1]; w10 = vAn[1][0]; w11 = vAn[1][1]; } }
            PG_LDB(B0, 0, 0); PG_LDB(B1, 0, 1); PG_SCHED; PG_LDA(At, 0, 0); PG_STAGE(PG_SA(1, 1), (a1) + hA, vA[1][0], vA[1][1]);
            PG_WAIT_V(8); PG_WAIT_L(0); PG_BAR; PG_MMA(0, 0, At, B0); PG_MMA(0, 1, At, B1); PG_BAR; PG_SCHED;
            PG_LDA(At, 0, 1); PG_STAGE(PG_SB(0, 0), b2, vB0, vB1); PG_STAGE(PG_SB(0, 1), (b2) + hB, vB0, vB1); PG_STAGE(PG_SA(0, 0), a2, w00, w01);
            PG_WAIT_V(8); PG_WAIT_L(0); PG_BAR; PG_MMA(1, 0, At, B0); PG_MMA(1, 1, At, B1); PG_BAR; PG_SCHED;
            PG_LDB(B0, 1, 0); PG_LDB(B1, 1, 1); PG_SCHED; PG_LDA(At, 1, 0); PG_STAGE(PG_SA(0, 1), (a2) + hA, w10, w11);
            PG_WAIT_V(8); PG_WAIT_L(0); PG_BAR; PG_MMA(0, 0, At, B0); PG_MMA(0, 1, At, B1); PG_BAR; PG_SCHED;
            PG_LDA(At, 1, 1); PG_STAGE(PG_SB(1, 0), b3, vB0, vB1); PG_STAGE(PG_SB(1, 1), (b3) + hB, vB0, vB1); PG_STAGE(PG_SA(1, 0), a3, w00, w01);
            PG_WAIT_V(8); PG_WAIT_L(0); PG_BAR; PG_MMA(1, 0, At, B0); PG_MMA(1, 1, At, B1); PG_BAR; PG_SCHED;
        }
        if (wr == 0) PG_BAR;
        E(acc, cur, wr, wc, fr, fq);
        if constexpr (EpiDup<Epi>::value) { asm volatile("" ::: "memory"); E(acc, cur, wr, wc, fr, fq); }
        if (!has_next) break;
#pragma unroll
        for (int a = 0; a < 2; ++a)
#pragma unroll
            for (int b = 0; b < 2; ++b)
#pragma unroll
                for (int m = 0; m < 4; ++m)
#pragma unroll
                    for (int n = 0; n < 2; ++n) acc[a][b][m][n] = (f32x4){0.f, 0.f, 0.f, 0.f};
        cur = nxt; cA = nA; cB = nB; ++ui;
        if constexpr (GATHER) { vA[0][0] = vAn[0][0]; vA[0][1] = vAn[0][1]; vA[1][0] = vAn[1][0]; vA[1][1] = vAn[1][1]; }
        if (wr == 1) PG_BAR;
    }
    PG_WAIT_V(0);
    PG_BAR;
#undef PG_SETVA
#undef PG_SA
#undef PG_SB
#undef PG_STAGE
#undef PG_LDA
#undef PG_LDB
#undef PG_MMA
#undef PG_WAIT_V
#undef PG_WAIT_L
#undef PG_BAR
#undef PG_SCHED
}

constexpr int NWAVES = 8, NTHR = 512;
constexpr int LDS_BYTES = 147456;
constexpr int MISC_OFF = 146432;
constexpr long long FX_ONE = 1ll << 36;
constexpr int CW_BAR = 4096;
constexpr int CW_TILECTR = 15360;
constexpr int CW_MODACC = 16384;

#define XB_TMO      128
#define XB_XCNT(j)  (256  + 64 * (j))
#define XB_XSUB(j)  (1280 + 64 * (j))
#define XB_XGEN(j)  (2304 + 64 * (j))
#define XB_TOP      3328
#define XB_TOPGEN   3392
#define XCD_BAR_WORDS 3456
#define XB_SPIN_CAP (1u << 18)
__device__ __forceinline__ unsigned xb_ld(unsigned* p)              { return __hip_atomic_load(p, __ATOMIC_RELAXED, __HIP_MEMORY_SCOPE_AGENT); }
__device__ __forceinline__ unsigned xb_add(unsigned* p, unsigned v) { return __hip_atomic_fetch_add(p, v, __ATOMIC_RELAXED, __HIP_MEMORY_SCOPE_AGENT); }
__device__ __forceinline__ unsigned xb_xcc_id() { return (unsigned)__builtin_amdgcn_s_getreg((3 << 11) | 20) & 0xFu; }
#define XB_SPIN(cond, bar) do { unsigned _sp = 0; while (cond) { __builtin_amdgcn_s_sleep(1); \
    if ((++_sp & 255u) == 0u) { if (xb_ld(&(bar)[XB_TMO])) break; if (_sp > XB_SPIN_CAP) { atomicAdd(&(bar)[XB_TMO], 1u); break; } } } } while (0)
struct XcdBarrier { unsigned* bar; unsigned x; volatile LAS unsigned* st; };
__device__ __forceinline__ XcdBarrier xcd_barrier_post(unsigned* bar, volatile LAS unsigned* st) {
    XcdBarrier b; b.bar = bar; b.x = xb_xcc_id(); b.st = st;
    if (threadIdx.x == 0) (void)xb_add(&bar[XB_XCNT(b.x)], 1u);
    return b;
}
__device__ __forceinline__ void xcd_barrier_complete(unsigned* bar, unsigned x, unsigned& nloc, unsigned& nx) {
    const unsigned G = gridDim.x * gridDim.y * gridDim.z;
    unsigned sum, cnt, mine, sp = 0u;
    for (;;) {
        sum = 0u; cnt = 0u; mine = 0u;
#pragma unroll
        for (unsigned j = 0; j < 16; ++j) { const unsigned c = xb_ld(&bar[XB_XCNT(j)]); sum += c; cnt += (c > 0u) ? 1u : 0u; mine = (j == x) ? c : mine; }
        if (sum == G) break;
        __builtin_amdgcn_s_sleep(1);
        if ((++sp & 255u) == 0u) { if (xb_ld(&bar[XB_TMO])) break; if (sp > XB_SPIN_CAP) { atomicAdd(&bar[XB_TMO], 1u); break; } }
    }
    nloc = mine > 0u ? mine : 1u; nx = cnt > 0u ? cnt : 1u;
}
__device__ __forceinline__ void xcd_barrier(const XcdBarrier& b) {
    asm volatile("s_waitcnt vmcnt(0)" ::: "memory");
    __syncthreads();
    if (threadIdx.x == 0) {
        unsigned* bar = b.bar;
        __builtin_amdgcn_s_waitcnt(0);
        unsigned nloc = b.st[0], nx = b.st[1];
        if (nloc == 0u) { xcd_barrier_complete(bar, b.x, nloc, nx); b.st[0] = nloc; b.st[1] = nx; }
        const unsigned old = xb_add(&bar[XB_XSUB(b.x)], 1u);
        const unsigned gen = old / nloc;
        if (old + 1u == (gen + 1u) * nloc) {
            __builtin_amdgcn_fence(__ATOMIC_RELEASE, "agent");
            asm volatile("s_waitcnt vmcnt(0)" ::: "memory");
            const unsigned og = xb_add(&bar[XB_TOP], 1u);
            const unsigned tg = og / nx;
            if (og + 1u == (tg + 1u) * nx) xb_add(&bar[XB_TOPGEN], 1u);
            else XB_SPIN(xb_ld(&bar[XB_TOPGEN]) == tg, bar);
            __builtin_amdgcn_fence(__ATOMIC_ACQUIRE, "agent");
            xb_add(&bar[XB_XGEN(b.x)], 1u);
            asm volatile("s_waitcnt vmcnt(0)" ::: "memory");
        } else {
            XB_SPIN(xb_ld(&bar[XB_XGEN(b.x)]) == gen, bar);
            __builtin_amdgcn_fence(__ATOMIC_ACQUIRE, "agent");
            asm volatile("s_waitcnt vmcnt(0)" ::: "memory");
        }
    }
    __syncthreads();
}

struct Args { const float* in[38]; float* out; unsigned char* ws; int ph_lo, ph_hi, li, pad; };
__device__ __forceinline__ float wsum(float v) {
#pragma unroll
    for (int o = 1; o < 64; o <<= 1) v += __shfl_xor(v, o);
    return v;
}
__device__ __forceinline__ unsigned pk2(float lo, float hi) { return (unsigned)f2bf(lo) | ((unsigned)f2bf(hi) << 16); }

enum { MAP_ID = 0, MAP_WIN = 1, MAP_EVEN = 2, MAP_ODD = 3 };
template <int MAP> __device__ __forceinline__ int dst_row(int n) {
    if (MAP == MAP_EVEN) return 2 * n;
    if (MAP == MAP_ODD) return 2 * n + 1;
    if (MAP == MAP_WIN) { if (n < 512) return n; if (n < 1024) return 512 + 2 * (n - 512); if (n < 1536) return 1536 + (n - 1024); if (n < 2048) return 512 + 2 * (n - 1536) + 1; return n; }
    return n;
}
template <int MAP, bool NTST = false>
__device__ __forceinline__ void transpose_tile(const float* W, int K, int N, bf16* WT, LAS float* scr, int item, int lane) {
    const int nblk = N / 64, kb = item / nblk, nb = item % nblk, k0 = 64 * kb, n0 = 64 * nb;
    const int lr = lane >> 4, lc = (lane & 15) * 4;
    f32x4 v[16];
#pragma unroll
    for (int i = 0; i < 16; ++i) v[i] = ldnt4(W + (size_t)(k0 + 4 * i + lr) * N + n0 + lc);
#pragma unroll
    for (int i = 0; i < 16; ++i) { LAS float* d = scr + (4 * i + lr) * 65 + lc; d[0] = v[i][0]; d[1] = v[i][1]; d[2] = v[i][2]; d[3] = v[i][3]; }
    asm volatile("s_waitcnt lgkmcnt(0)" ::: "memory");
    const int c = lane & 7;
#pragma unroll
    for (int j = 0; j < 8; ++j) { const int n = (lane >> 3) + 8 * j; const LAS float* sp = scr + (8 * c) * 65 + n;
        u32x4 o; o.x = cvt_pk_bf16(sp[0 * 65], sp[1 * 65]); o.y = cvt_pk_bf16(sp[2 * 65], sp[3 * 65]); o.z = cvt_pk_bf16(sp[4 * 65], sp[5 * 65]); o.w = cvt_pk_bf16(sp[6 * 65], sp[7 * 65]);
        if (NTST) __builtin_nontemporal_store(o, (u32x4*)(WT + (size_t)dst_row<MAP>(n0 + n) * K + k0 + 8 * c)); else *(u32x4*)(WT + (size_t)dst_row<MAP>(n0 + n) * K + k0 + 8 * c) = o; }
    asm volatile("s_waitcnt lgkmcnt(0)" ::: "memory");
}

struct EpiInProj { bf16* UG; bf16* WC; bf16* GB; bf16* SA; bf16* SB;
    __device__ __forceinline__ void operator()(const f32x4 (&acc)[2][2][4][2], const GUnit& u, int wr, int wc, int fr, int fq) const {
        const int row0 = u.pm * BM + wr * 64 + fr, colb = u.pn * BM + wc * 32 + 8 * fq;
#pragma unroll
        for (int ai = 0; ai < 2; ++ai)
#pragma unroll
            for (int m = 0; m < 4; ++m) { const int row = row0 + ai * HALF + m * 16;
#pragma unroll
                for (int bj = 0; bj < 2; ++bj) { const int col = colb + bj * HALF; const f32x4 v0 = acc[ai][bj][m][0], v1 = acc[ai][bj][m][1];
                    if (u.pn < 2) { u32x4 w; w.x = cvt_pk_bf16(v0[0], v0[1]); w.y = cvt_pk_bf16(v0[2], v0[3]); w.z = cvt_pk_bf16(v1[0], v1[1]); w.w = cvt_pk_bf16(v1[2], v1[3]);
                        *(u32x4*)(UG + ug_index(row, col)) = w; }
                    else if (u.pn < 6) { u32x2 w; w.x = cvt_pk_bf16(v0[0] * v0[1], v0[2] * v0[3]); w.y = cvt_pk_bf16(v1[0] * v1[1], v1[2] * v1[3]);
                        *(u32x2*)(WC + (size_t)row * 512 + ((col - 512) >> 1)) = w; }
                    else if (u.pn < 8) { u32x4 w; w.x = cvt_pk_bf16(v0[0], v0[1]); w.y = cvt_pk_bf16(v0[2], v0[3]); w.z = cvt_pk_bf16(v1[0], v1[1]); w.w = cvt_pk_bf16(v1[2], v1[3]);
                        *(u32x4*)(GB + (size_t)row * 512 + (col - 1536)) = w; }
                    else { u32x4 w; w.x = cvt_pk_bf16(fsigmoid(v0[0]), fsigmoid(v0[1])); w.y = cvt_pk_bf16(fsigmoid(v0[2]), fsigmoid(v0[3])); w.z = cvt_pk_bf16(fsigmoid(v1[0]), fsigmoid(v1[1])); w.w = cvt_pk_bf16(fsigmoid(v1[2]), fsigmoid(v1[3]));
                        bf16* dst = (col < 3072) ? SA + (size_t)row * D + (col - 2048) : SB + (size_t)row * D + (col - 3072);
                        __builtin_nontemporal_store(w, (u32x4*)dst); } } }
    }
};
template <> struct EpiDup<EpiInProj> { static constexpr bool value = (DUPEPI & 1) != 0; };
struct SchedInProj { const char* XN; const char* WT; int G, c;
    __device__ __forceinline__ bool next(int i, GUnit& u) const {
        int pm, pn;
        if ((SDUP >> 2) & 1) { const int nc = 8; if (i >= 2 * nc) return false; if (i >= nc) i -= nc; }
        if (!static_order(i, G, c, 128, 16, pm, pn)) return false;
        u.pm = pm; u.pn = pn; u.A = XN + (size_t)pm * BM * (D * 2); u.B = WT + (size_t)pn * BM * (D * 2); u.ridx = nullptr; u.aux0 = 0; u.aux1 = 0; return true; }
};


struct MEpiGlu { bf16* TMP; const bf16* SA;
    __device__ __forceinline__ void operator()(const f32x4 (&acc)[2][2][4][2], const GUnit& u, int wr, int wc, int fr, int fq) const {
        const int row0 = u.pm * BM + wr * 64 + fr, colb = u.pn * BM + wc * 32 + 8 * fq;
        u32x2 sa[2][4][2];
#pragma unroll
        for (int ai = 0; ai < 2; ++ai)
#pragma unroll
            for (int m = 0; m < 4; ++m)
#pragma unroll
                for (int bj = 0; bj < 2; ++bj) sa[ai][m][bj] = ldnt2u(SA + (size_t)(row0 + ai * HALF + m * 16) * D + ((colb + bj * HALF) >> 1));
        __builtin_amdgcn_sched_barrier(0);
#pragma unroll
        for (int ai = 0; ai < 2; ++ai)
#pragma unroll
            for (int m = 0; m < 4; ++m) { const int row = row0 + ai * HALF + m * 16;
#pragma unroll
                for (int bj = 0; bj < 2; ++bj) { const int j0 = (colb + bj * HALF) >> 1; const f32x4 v0 = acc[ai][bj][m][0], v1 = acc[ai][bj][m][1]; const u32x2 q = sa[ai][m][bj];
                    u32x2 w; w.x = cvt_pk_bf16(v0[0] * fsigmoid(v0[1]) * blo(q.x), v0[2] * fsigmoid(v0[3]) * bhi(q.x)); w.y = cvt_pk_bf16(v1[0] * fsigmoid(v1[1]) * blo(q.y), v1[2] * fsigmoid(v1[3]) * bhi(q.y));
                    *(u32x2*)(TMP + (size_t)row * D + j0) = w; } }
    }
};
struct MEpiCv { bf16* MG; const bf16* TMP; const bf16* SB;
    __device__ __forceinline__ void operator()(const f32x4 (&acc)[2][2][4][2], const GUnit& u, int wr, int wc, int fr, int fq) const {
        const int row0 = u.pm * BM + wr * 64 + fr, colb = u.pn * BM + wc * 32 + 8 * fq;
#pragma unroll
        for (int ai = 0; ai < 2; ++ai) { u32x4 tt[4][2], ss[4][2];
#pragma unroll
            for (int m = 0; m < 4; ++m)
#pragma unroll
                for (int bj = 0; bj < 2; ++bj) { const size_t idx = (size_t)(row0 + ai * HALF + m * 16) * D + colb + bj * HALF; tt[m][bj] = ldnt4u(TMP + idx); ss[m][bj] = ldnt4u(SB + idx); }
            __builtin_amdgcn_sched_barrier(0);
#pragma unroll
            for (int m = 0; m < 4; ++m)
#pragma unroll
                for (int bj = 0; bj < 2; ++bj) { const size_t idx = (size_t)(row0 + ai * HALF + m * 16) * D + colb + bj * HALF; const f32x4 v0 = acc[ai][bj][m][0], v1 = acc[ai][bj][m][1]; const u32x4 t = tt[m][bj], sb = ss[m][bj];
                    u32x4 w; w.x = cvt_pk_bf16(blo(t.x) + blo(sb.x) * v0[0], bhi(t.x) + bhi(sb.x) * v0[1]); w.y = cvt_pk_bf16(blo(t.y) + blo(sb.y) * v0[2], bhi(t.y) + bhi(sb.y) * v0[3]);
                    w.z = cvt_pk_bf16(blo(t.z) + blo(sb.z) * v1[0], bhi(t.z) + bhi(sb.z) * v1[1]); w.w = cvt_pk_bf16(blo(t.w) + blo(sb.w) * v1[2], bhi(t.w) + bhi(sb.w) * v1[3]);
                    *(u32x4*)(MG + idx) = w; }
            __builtin_amdgcn_sched_barrier(0); }
    }
};
struct MEpiWo { bf16* MIXG; const float* MODF;
    __device__ __forceinline__ void operator()(const f32x4 (&acc)[2][2][4][2], const GUnit& u, int wr, int wc, int fr, int fq) const {
        const int row0 = u.pm * BM + wr * 64 + fr, colb = u.pn * BM + wc * 32 + 8 * fq;
        const float* g1 = MODF + (size_t)(u.pm * BM / L) * 6144 + 2048 + colb;
        f32x4 gg[2][2];
#pragma unroll
        for (int bj = 0; bj < 2; ++bj)
#pragma unroll
            for (int n = 0; n < 2; ++n) gg[bj][n] = *(const f32x4*)(g1 + bj * HALF + 4 * n);
#pragma unroll
        for (int ai = 0; ai < 2; ++ai)
#pragma unroll
            for (int m = 0; m < 4; ++m) { const int row = row0 + ai * HALF + m * 16;
#pragma unroll
                for (int bj = 0; bj < 2; ++bj) { const f32x4 v0 = acc[ai][bj][m][0] * gg[bj][0], v1 = acc[ai][bj][m][1] * gg[bj][1];
                    u32x4 w; w.x = cvt_pk_bf16(v0[0], v0[1]); w.y = cvt_pk_bf16(v0[2], v0[3]); w.z = cvt_pk_bf16(v1[0], v1[1]); w.w = cvt_pk_bf16(v1[2], v1[3]);
                    *(u32x4*)(MIXG + (size_t)row * D + colb + bj * HALF) = w; } }
    }
};
struct EpiLogit { float* LOGIT;
    __device__ __forceinline__ void operator()(const f32x4 (&acc)[2][2][4][2], const GUnit& u, int wr, int wc, int fr, int fq) const {
        if (wc >= 2) return;
        const int row0 = u.pm * BM + wr * 64 + fr, col = wc * 32 + 8 * fq;
#pragma unroll
        for (int ai = 0; ai < 2; ++ai)
#pragma unroll
            for (int m = 0; m < 4; ++m) { const int row = row0 + ai * HALF + m * 16;
                *(f32x4*)(LOGIT + (size_t)row * 64 + col) = acc[ai][0][m][0]; *(f32x4*)(LOGIT + (size_t)row * 64 + col + 4) = acc[ai][0][m][1]; }
    }
};
struct MEpiHid { bf16* HID;
    __device__ __forceinline__ void operator()(const f32x4 (&acc)[2][2][4][2], const GUnit& u, int wr, int wc, int fr, int fq) const {
        const int row0 = u.pm * BM + wr * 64 + fr, colb = u.pn * BM + wc * 32 + 8 * fq;
#pragma unroll
        for (int ai = 0; ai < 2; ++ai)
#pragma unroll
            for (int m = 0; m < 4; ++m) { const int row = row0 + ai * HALF + m * 16;
#pragma unroll
                for (int bj = 0; bj < 2; ++bj) { const int j0 = (colb + bj * HALF) >> 1; const f32x4 v0 = acc[ai][bj][m][0], v1 = acc[ai][bj][m][1];
                    u32x2 w; w.x = cvt_pk_bf16(v0[0] * fsigmoid(v0[0]) * v0[1], v0[2] * fsigmoid(v0[2]) * v0[3]); w.y = cvt_pk_bf16(v1[0] * fsigmoid(v1[0]) * v1[1], v1[2] * fsigmoid(v1[2]) * v1[3]);
                    *(u32x2*)(HID + (size_t)row * FF + j0) = w; } }
    }
};
struct MEpiDown { bf16* Y2; const int* asg; const float* wslot;
    __device__ __forceinline__ void operator()(const f32x4 (&acc)[2][2][4][2], const GUnit& u, int wr, int wc, int fr, int fq) const {
        if (NOEPI_DUP && u.aux1) return;
        const int row0 = u.pm * BM + wr * 64 + fr, colb = u.pn * BM + wc * 32 + 8 * fq;
        int as[2][4]; float wv[2][4];
#pragma unroll
        for (int ai = 0; ai < 2; ++ai)
#pragma unroll
            for (int m = 0; m < 4; ++m) { as[ai][m] = asg[row0 + ai * HALF + m * 16]; wv[ai][m] = wslot[row0 + ai * HALF + m * 16]; }
        __builtin_amdgcn_sched_barrier(0);
#pragma unroll
        for (int ai = 0; ai < 2; ++ai)
#pragma unroll
            for (int m = 0; m < 4; ++m) { const int a_ = as[ai][m];
                if (a_ >= 0) { const float w_ = wv[ai][m];
#pragma unroll
                    for (int bj = 0; bj < 2; ++bj) { const f32x4 v0 = acc[ai][bj][m][0] * w_, v1 = acc[ai][bj][m][1] * w_;
                        u32x4 w; w.x = cvt_pk_bf16(v0[0], v0[1]); w.y = cvt_pk_bf16(v0[2], v0[3]); w.z = cvt_pk_bf16(v1[0], v1[1]); w.w = cvt_pk_bf16(v1[2], v1[3]);
                        *(u32x4*)(Y2 + (size_t)a_ * D + colb + bj * HALF) = w; } } }
    }
};

struct EpiSend { float* SEND;
    __device__ __forceinline__ void operator()(const f32x4 (&acc)[2][2][4][2], const GUnit& u, int wr, int wc, int fr, int fq) const {
        const int row0 = u.pm * BM + wr * 64 + fr, colb = wc * 32 + 8 * fq; float* base = SEND + (size_t)u.aux0 * NCR * 256;
#pragma unroll
        for (int ai = 0; ai < 2; ++ai)
#pragma unroll
            for (int m = 0; m < 4; ++m) { const int row = row0 + ai * HALF + m * 16;
#pragma unroll
                for (int bj = 0; bj < 2; ++bj) { float* dst = base + (size_t)row * 256 + colb + bj * HALF; *(f32x4*)dst = acc[ai][bj][m][0]; *(f32x4*)(dst + 4) = acc[ai][bj][m][1]; } }
    }
};
struct SchedSend { const char* UG; const char* PM; int G, c;
    __device__ __forceinline__ bool next(int i, GUnit& u) const { if ((SDUP >> 3) & 1) { const int nc = (160 - c + G - 1) / G; if (nc <= 0 || i >= 2 * nc) return false; if (i >= nc) i -= nc; }
        const int Lx = i * G + c; if (Lx >= 160) return false; const int g = Lx / 5, pm = Lx % 5;
        u.pm = pm; u.pn = 0; u.aux0 = g; u.aux1 = 0; u.ridx = nullptr; u.A = UG + ((size_t)g * NCR + (size_t)pm * BM) * (UGK * 2); u.B = PM + (size_t)g * 256 * 512 * 2; return true; }
};
struct EpiY { bf16* YA;
    __device__ __forceinline__ void operator()(const f32x4 (&acc)[2][2][4][2], const GUnit& u, int wr, int wc, int fr, int fq) const {
        const int row0 = u.pm * BM + wr * 64 + fr, colb = u.pn * BM + wc * 32 + 8 * fq; const int g = u.aux0;
#pragma unroll
        for (int ai = 0; ai < 2; ++ai)
#pragma unroll
            for (int m = 0; m < 4; ++m) { const int crow = row0 + ai * HALF + m * 16;
#pragma unroll
                for (int bj = 0; bj < 2; ++bj) { const int col = colb + bj * HALF; const int to = col >> 4, co0 = col & 15; f32x4 v0 = acc[ai][bj][m][0], v1 = acc[ai][bj][m][1];
#pragma unroll
                    for (int k = 0; k < 4; ++k) { v0[k] = v0[k] * fsigmoid(1.5957691216f * (v0[k] + 0.044715f * v0[k] * v0[k] * v0[k])); v1[k] = v1[k] * fsigmoid(1.5957691216f * (v1[k] + 0.044715f * v1[k] * v1[k] * v1[k])); }
                    u32x4 w; w.x = cvt_pk_bf16(v0[0], v0[1]); w.y = cvt_pk_bf16(v0[2], v0[3]); w.z = cvt_pk_bf16(v1[0], v1[1]); w.w = cvt_pk_bf16(v1[2], v1[3]);
                    *(u32x4*)(YA + ((size_t)crow * 32 + to) * 512 + g * 16 + co0) = w; } }
    }
};
struct SchedY { const char* UG; const char* TM; int G, c;
    __device__ __forceinline__ bool next(int i, GUnit& u) const { if ((SDUP >> 5) & 1) { const int nc = (256 - c + G - 1) / G; if (nc <= 0 || i >= 2 * nc) return false; if (i >= nc) i -= nc; }
        const int Lx = i * G + c; if (Lx >= 256) return false; const int g = Lx >> 3, pm = (Lx >> 1) & 3, pn = Lx & 1;
        u.pm = pm; u.pn = pn; u.aux0 = g; u.aux1 = 0; u.ridx = nullptr; u.A = UG + ((size_t)g * NCR + (size_t)pm * BM) * (UGK * 2); u.B = TM + ((size_t)g * 512 + (size_t)pn * BM) * (UGK * 2); return true; }
};
template <> struct EpiDup<MEpiDown> { static constexpr bool value = (DUPEPI & 2) != 0; };
template <> struct EpiDup<MEpiHid> { static constexpr bool value = (DUPEPI & 4) != 0; };
struct SchedGrid { const char* A; const char* B; int G, c, nM, nN; unsigned lda, ldb; int dup;
    __device__ __forceinline__ bool next(int i, GUnit& u) const { int pm, pn;
        if (dup) { const int nc = (nM * nN - c + G - 1) / G; if (i >= 2 * nc) return false; if (i >= nc) i -= nc; }
        if (!static_order(i, G, c, nM, nN, pm, pn)) return false;
        u.pm = pm; u.pn = pn; u.A = A + (size_t)pm * BM * lda; u.B = B + (size_t)pn * BM * ldb; u.ridx = nullptr; u.aux0 = 0; u.aux1 = 0; return true; }
};
struct SchedGluPair { const char* A; const char* B; int G, c; int dup;
    __device__ __forceinline__ bool next(int i, GUnit& u) const { int pm, q;
        if (dup) { const int nc = 2 * ((512 - c + G - 1) / G); if (i >= 2 * nc) return false; if (i >= nc) i -= nc; }
        if (!static_order(i >> 1, G, c, 128, 4, pm, q)) return false;
        u.pm = pm; u.pn = 2 * q + (i & 1); u.A = A + (size_t)pm * BM * 1024u; u.B = B + (size_t)u.pn * BM * 1024u; u.ridx = nullptr; u.aux0 = 0; u.aux1 = 0; return true; }
};
struct SchedExp { const char* A; const char* W; const int* ridx; const int* meta; int G, c; unsigned lda, ldb; size_t wstride; int gather; int dup;
    __device__ __forceinline__ bool next(int i, GUnit& u) const { const int np = meta[32] >> 8;
        int isdup = 0; if (dup) { const int nc = (4 * np - c + G - 1) / G; if (i >= 2 * nc) return false; if (i >= nc) { i -= nc; isdup = 1; } }
        const int Lx = i * G + c; const int p = Lx >> 2, pn = Lx & 3; if (p >= np) return false;
        int e = 0;
#pragma unroll 1
        for (int k = 1; k < 32; ++k) e = (meta[k] <= (p << 8)) ? k : e;
        u.pm = p; u.pn = pn; u.A = gather ? A : A + (size_t)p * BM * lda; u.B = W + (size_t)e * wstride + (size_t)pn * BM * ldb; u.ridx = ridx + (p << 8); u.aux0 = e; u.aux1 = isdup; return true; }
};

__global__ void __launch_bounds__(NTHR, 2) fwd(Args args) {
    __shared__ __attribute__((aligned(1024))) unsigned char lds_raw[LDS_BYTES];
    LAS unsigned char* lds = (LAS unsigned char*)lds_raw;
    volatile LAS unsigned* MISC = (volatile LAS unsigned*)(lds + MISC_OFF);
    const int tid = threadIdx.x, lane = tid & 63, wave = __builtin_amdgcn_readfirstlane(tid >> 6);
    const int G = gridDim.x, bx = blockIdx.x;
    unsigned char* ws = args.ws;
    unsigned* ctl = (unsigned*)(ws + WS_CTL);
    for (int u = tid; u < (LDS_BYTES - MISC_OFF) / 4; u += NTHR) ((LAS unsigned*)(lds + MISC_OFF))[u] = 0u;
    __syncthreads();
    XcdBarrier bar = xcd_barrier_post(ctl + CW_BAR + args.li * XCD_BAR_WORDS, MISC + 8);
    const int lo = args.ph_lo, hi = args.ph_hi;
#define IN(k) (lo <= (k) && (k) < hi)
#define BOTH(k) (IN(k) && IN((k) + 1))
    const int gw = bx * NWAVES + wave, NGW = G * NWAVES;
    long long* modacc = (long long*)(ctl + CW_MODACC);
    float* MODF = (float*)(ws + WS_MOD);
    float* POSR = (float*)(ws + WS_POS); float* POSC = POSR + 128 * 512;
    bf16* Win_t = (bf16*)(ws + WS_WIN);
    bf16* XN = (bf16*)(ws + WS_RA); bf16* UG = (bf16*)(ws + WS_RB);
    bf16* WC = (bf16*)(ws + WS_RD); bf16* GB = (bf16*)(ws + WS_RD + 32 * MiB);
    bf16* SA = (bf16*)args.out; bf16* SB = SA + (size_t)T * D;
    bf16* Wglu_t = (bf16*)(ws + WS_WGLU); bf16* Wcv_t = (bf16*)(ws + WS_WCV); bf16* Wo_t = (bf16*)(ws + WS_WO); bf16* Wr_t = (bf16*)(ws + WS_WR); bf16* Wgu_t = (bf16*)(ws + WS_WGU); bf16* Wd_t = (bf16*)(ws + WS_WD);
    bf16* YA = (bf16*)(ws + WS_RD); bf16* A2 = (bf16*)(ws + WS_RD + 64 * MiB); bf16* TMP = (bf16*)(ws + WS_RA); bf16* MG = (bf16*)(ws + WS_RB);
    bf16* MIXG = (bf16*)(ws + WS_RD); bf16* X1B = (bf16*)(ws + WS_END);
    bf16* H2 = (bf16*)(ws + WS_RA); bf16* HID = (bf16*)(ws + WS_RB); bf16* Y2 = (bf16*)(ws + WS_RD); float* LOGIT = (float*)(ws + WS_LOGIT);
    unsigned char* rt = ws + WS_ROUT; int* eidx = (int*)(rt + RT_EIDX); float* wgt = (float*)(rt + RT_WGT); int* tokl = (int*)(rt + RT_TOK); int* asgl = (int*)(rt + RT_ASG);
    float* TAPG = (float*)(ws + WS_LOGIT); float* PWG = (float*)(ws + WS_LOGIT + 2 * MiB); float* BBG = (float*)(ws + WS_LOGIT + 4 * MiB);
    bf16* Pm = (bf16*)(ws + WS_PM); bf16* Tm = (bf16*)(ws + WS_TM); float* SEND = (float*)(ws + WS_RA);
    float* wsl = (float*)(rt + RT_META + 64 * 1024);
    int* hist = (int*)(rt + RT_HIST); int* rankl = (int*)(rt + RT_RANK); int* meta = (int*)(rt + RT_META);

    if (IN(0)) {
        for (int rep_ = 0; rep_ < ((DUPMASK >> 0) & 1) + 1; ++rep_) {
        for (int r4_ = 0; r4_ < ((DUPMASK >> 18) & 1) + 1; ++r4_)
        if (rep_ == 0) {
            const float* w_ada = args.in[4];
            for (int it = gw; it < 96 * 16; it += NGW) { const int ct = it % 96, ks = it / 96; const int col = ct * 64 + lane, k0 = ks * 64;
                float cvv[5], wv[64];
#pragma unroll
                for (int v = 0; v < 5; ++v) cvv[v] = (v < 4) ? args.in[1][v * 1024 + k0 + lane] : args.in[3][k0 + lane];
#pragma unroll
                for (int k = 0; k < 64; ++k) wv[k] = __builtin_nontemporal_load(w_ada + (size_t)(k0 + k) * 6144 + col);
                __builtin_amdgcn_sched_barrier(0);
                float sv[5];
#pragma unroll
                for (int v = 0; v < 5; ++v) sv[v] = cvv[v] * fsigmoid(cvv[v]);
                float a0 = 0.f, a1 = 0.f, a2 = 0.f, a3 = 0.f, a4 = 0.f;
#pragma unroll
                for (int k = 0; k < 64; ++k) { const float w = wv[k];
                    a0 += __builtin_bit_cast(float, __builtin_amdgcn_readlane(__builtin_bit_cast(int, sv[0]), k)) * w; a1 += __builtin_bit_cast(float, __builtin_amdgcn_readlane(__builtin_bit_cast(int, sv[1]), k)) * w;
                    a2 += __builtin_bit_cast(float, __builtin_amdgcn_readlane(__builtin_bit_cast(int, sv[2]), k)) * w; a3 += __builtin_bit_cast(float, __builtin_amdgcn_readlane(__builtin_bit_cast(int, sv[3]), k)) * w;
                    a4 += __builtin_bit_cast(float, __builtin_amdgcn_readlane(__builtin_bit_cast(int, sv[4]), k)) * w; }
                const float sc = (float)FX_ONE;
                __hip_atomic_fetch_add(modacc + r4_ * 30720 + 0 * 6144 + col, (long long)(a0 * sc), __ATOMIC_RELAXED, __HIP_MEMORY_SCOPE_AGENT);
                __hip_atomic_fetch_add(modacc + r4_ * 30720 + 1 * 6144 + col, (long long)(a1 * sc), __ATOMIC_RELAXED, __HIP_MEMORY_SCOPE_AGENT);
                __hip_atomic_fetch_add(modacc + r4_ * 30720 + 2 * 6144 + col, (long long)(a2 * sc), __ATOMIC_RELAXED, __HIP_MEMORY_SCOPE_AGENT);
                __hip_atomic_fetch_add(modacc + r4_ * 30720 + 3 * 6144 + col, (long long)(a3 * sc), __ATOMIC_RELAXED, __HIP_MEMORY_SCOPE_AGENT);
                __hip_atomic_fetch_add(modacc + r4_ * 30720 + 4 * 6144 + col, (long long)(a4 * sc), __ATOMIC_RELAXED, __HIP_MEMORY_SCOPE_AGENT); }
        }
        for (int i = bx * NTHR + tid; i < 192 * 512; i += G * NTHR) {
            const int p = i >> 9, d = i & 511; const int pp = p < 128 ? p : p - 128; const int ii = d & 255;
            const float omega = exp2f(-(float)ii * (13.287712379549449f / 256.0f)); const float a = (float)pp * omega;
            POSR[i] = (d < 256) ? sinf(a) : cosf(a); }
        const bool s5blk = (G == 256) ? ((bx & 3) == ((bx >> 2) & 3)) : (bx < 64);
        __syncthreads();
        for (int r2_ = 0; r2_ < ((DUPMASK >> 16) & 1) + 1; ++r2_)
        if (s5blk) {
            const int item = (G == 256) ? (bx >> 2) : bx; const int g = item >> 1, d = item & 1, pb = d ? 14 : 7;
            LAS float* PW = (LAS float*)lds;
            LAS float* BB = PW + 4224;
            LAS float* CC = BB + 2048;
            LAS float* LT = CC + 2048;
            if (tid < 64) { const int n = tid;
                const float dt = expf(args.in[pb][g]); const float are = args.in[pb + 1][g * NS + n], aim = args.in[pb + 2][g * NS + n];
                const float lnm = dt * are, th = dt * aim; const float mag = expf(lnm); const float abr = mag * cosf(th), abi = mag * sinf(th);
                const float den = are * are + aim * aim, xr = abr - 1.f; const float fr_ = (xr * are + abi * aim) / den, fi_ = (abi * are - xr * aim) / den;
                LT[n * 2] = lnm; LT[n * 2 + 1] = th;
                f32x4 brv[4], biv[4];
#pragma unroll
                for (int q = 0; q < 4; ++q) { brv[q] = *(const f32x4*)(args.in[pb + 3] + (g * NS + n) * 16 + 4 * q); biv[q] = *(const f32x4*)(args.in[pb + 4] + (g * NS + n) * 16 + 4 * q); }
                __builtin_amdgcn_sched_barrier(0);
#pragma unroll
                for (int q = 0; q < 4; ++q)
#pragma unroll
                    for (int k = 0; k < 4; ++k) { const int c = 4 * q + k; const float br = brv[q][k], bi = biv[q][k]; const float vr = fr_ * br - fi_ * bi, vi = fr_ * bi + fi_ * br;
                        BB[(n * 16 + c) * 2] = vr; BB[(n * 16 + c) * 2 + 1] = vi; BBG[((size_t)item * 1024 + n * 16 + c) * 2] = vr; BBG[((size_t)item * 1024 + n * 16 + c) * 2 + 1] = vi; } }
            { float cr_[2], ci_[2];
#pragma unroll
              for (int q = 0; q < 2; ++q) { const int i = tid + q * NTHR; cr_[q] = args.in[pb + 5][g * 1024 + i]; ci_[q] = args.in[pb + 6][g * 1024 + i]; }
              __builtin_amdgcn_sched_barrier(0);
#pragma unroll
              for (int q = 0; q < 2; ++q) { const int i = tid + q * NTHR; CC[i * 2] = cr_[q]; CC[i * 2 + 1] = ci_[q]; } }
            __syncthreads();
            for (int i = tid; i < 33 * 64; i += NTHR) { const int n = i & 63, j = i >> 6; const float lnm = LT[n * 2], th = LT[n * 2 + 1];
                const float mj = __expf((float)j * lnm); const float vr = mj * __cosf((float)j * th), vi = mj * __sinf((float)j * th);
                PW[i * 2] = vr; PW[i * 2 + 1] = vi; PWG[((size_t)item * 2112 + i) * 2] = vr; PWG[((size_t)item * 2112 + i) * 2 + 1] = vi; }
            __syncthreads();
            { const int j = tid >> 4, co = tid & 15; float ta[16];
#pragma unroll
              for (int c = 0; c < 16; ++c) ta[c] = 0.f;
              const LAS float* pwp = PW + (j * 64) * 2; const LAS float* ccp = CC + (co * 64) * 2; const LAS f32x4* bbp = (const LAS f32x4*)BB;
#pragma unroll 2
              for (int n = 0; n < 64; ++n) { const float pr = pwp[2 * n], pi = pwp[2 * n + 1], cr = ccp[2 * n], ci = ccp[2 * n + 1];
                  const float cpr = cr * pr - ci * pi, cpi = cr * pi + ci * pr;
#pragma unroll
                  for (int q = 0; q < 8; ++q) { const f32x4 b = bbp[n * 8 + q]; ta[2 * q] += cpr * b[0] - cpi * b[1]; ta[2 * q + 1] += cpr * b[2] - cpi * b[3]; } }
              float* tg = TAPG + ((size_t)item * 32 + j) * 256 + co * 16;
#pragma unroll
              for (int q = 0; q < 4; ++q) *(f32x4*)(tg + 4 * q) = (f32x4){ta[4 * q], ta[4 * q + 1], ta[4 * q + 2], ta[4 * q + 3]}; }
            __syncthreads();
        }
        {
            LAS float* scr = (LAS float*)(lds + wave * 16640);
            const int s5rank = (G == 256) ? (bx >> 2) : bx, orank = (G == 256) ? (bx - ((bx >> 2) + (((bx & 3) > ((bx >> 2) & 3)) ? 1 : 0))) : (bx - 64);
            const int t_lo = s5blk ? 0 : 2048, t_hi = s5blk ? 2048 : 13952, t_first = t_lo + (s5blk ? s5rank : orank) * NWAVES + wave, t_step = (s5blk ? 64 : (G - 64)) * NWAVES;
            for (int r3_ = 0; r3_ < ((DUPMASK >> 17) & 1) + 1; ++r3_)
            {
            for (int it = t_first; it < t_hi; it += t_step) {
                int r = it;
                if (r < 1024) { transpose_tile<MAP_WIN>(args.in[6], D, INW, Win_t, scr, r, lane); }
                else if ((r -= 1024) < 128) { transpose_tile<MAP_EVEN>(args.in[22], 512, D, Wglu_t, scr, r, lane); }
                else if ((r -= 128) < 128) { transpose_tile<MAP_ODD>(args.in[23], 512, D, Wglu_t, scr, r, lane); }
                else if ((r -= 128) < 128) { transpose_tile<MAP_ID>(args.in[25], 512, D, Wcv_t, scr, r, lane); }
                else if ((r -= 128) < 256) { transpose_tile<MAP_ID>(args.in[26], D, D, Wo_t, scr, r, lane); }
                else if ((r -= 256) < 4096) { const int e = r >> 7; transpose_tile<MAP_EVEN, true>(args.in[33] + (size_t)e * D * FF, D, FF, Wgu_t + (size_t)e * D * D, scr, r & 127, lane); }
                else if ((r -= 4096) < 4096) { const int e = r >> 7; transpose_tile<MAP_ODD, true>(args.in[34] + (size_t)e * D * FF, D, FF, Wgu_t + (size_t)e * D * D, scr, r & 127, lane); }
                else { r -= 4096; const int e = r >> 7; transpose_tile<MAP_ID, true>(args.in[35] + (size_t)e * FF * D, FF, D, Wd_t + (size_t)e * D * FF, scr, r & 127, lane); }
            }
            }
            for (int i = bx * NTHR + tid; i < 256 * D; i += G * NTHR) { const int n = i >> 10, k = i & 1023;
                const float v = (n < 4) ? args.in[29][k * 4 + n] : (n < 36) ? args.in[31][k * 32 + (n - 4)] : 0.f; Wr_t[i] = f2bf(v); }
        }
        }
        if (BOTH(0)) { xcd_barrier(bar); if (DUPBAR) xcd_barrier(bar); }
    }
    if (IN(1)) {
        for (int rep_ = 0; rep_ < ((DUPMASK >> 1) & 1) + 1; ++rep_) {
        for (int item = bx; item < 256; item += G) {
            const int g = item >> 3, part = item & 7;
            LAS float* PW = (LAS float*)lds;
            LAS float* BB = PW + 8448;
            LAS float* CC = BB + 4096;
            LAS float* TAP = CC + 4096;
            LAS float* DK = TAP + 16384;
            if (part < 4) {
                f32x4 t8[8];
#pragma unroll
                for (int q = 0; q < 8; ++q) t8[q] = *(const f32x4*)(TAPG + (size_t)g * 16384 + (size_t)(q * NTHR + tid) * 4);
                __builtin_amdgcn_sched_barrier(0);
#pragma unroll
                for (int q = 0; q < 8; ++q) *(LAS f32x4*)(TAP + (q * NTHR + tid) * 4) = t8[q];
                if (tid < 16) DK[tid] = args.in[21][g * 16 + tid];
                __syncthreads();
                for (int idx = tid; idx < 128 * 256; idx += NTHR) { const int rl = idx >> 8, kp = idx & 255; const int row = 128 * part + rl, to = row >> 4, co = row & 15, k = 2 * kp, ti = k >> 4, ci = k & 15;
                    float v0 = 0.f, v1 = 0.f;
                    if (to >= ti) { v0 += TAP[(to - ti) * 256 + co * 16 + ci]; v1 += TAP[(to - ti) * 256 + co * 16 + ci + 1]; }
                    if (to <= ti) { v0 += TAP[(32 + ti - to) * 256 + co * 16 + ci]; v1 += TAP[(32 + ti - to) * 256 + co * 16 + ci + 1]; }
                    if (to == ti) { const float dk = DK[co]; if (co == ci) v0 += dk; if (co == ci + 1) v1 += dk; }
                    *(unsigned*)(Tm + ((size_t)g * 512 + row) * UGK + k) = pk2(v0, v1); }
            } else if (part < 6) {
                for (int i = tid; i < 2112; i += NTHR) *(LAS f32x4*)(PW + i * 4) = *(const f32x4*)(PWG + (size_t)g * 8448 + (size_t)i * 4);
                { float cr_[4], ci_[4];
#pragma unroll
                  for (int q = 0; q < 4; ++q) { const int i = tid + q * NTHR; const int d = i >> 10, rem = i & 1023; const int pb = d ? 14 : 7; cr_[q] = args.in[pb + 5][g * 1024 + rem]; ci_[q] = args.in[pb + 6][g * 1024 + rem]; }
                  __builtin_amdgcn_sched_barrier(0);
#pragma unroll
                  for (int q = 0; q < 4; ++q) { const int i = tid + q * NTHR; CC[i * 2] = cr_[q]; CC[i * 2 + 1] = ci_[q]; } }
                __syncthreads();
                for (int idx = tid; idx < 256 * 128; idx += NTHR) { const int rl = idx >> 7, kp = idx & 127; const int row = 256 * (part - 4) + rl, to = row >> 4, co = row & 15, kk = 2 * kp, d = kk >> 7, reim = (kk >> 6) & 1, n = kk & 63;
                    const int j = d ? 32 - to : to + 1; float vv[2];
#pragma unroll
                    for (int q = 0; q < 2; ++q) { const float pr = PW[((d * 33 + j) * 64 + n + q) * 2], pi = PW[((d * 33 + j) * 64 + n + q) * 2 + 1], cr = CC[((d * 16 + co) * 64 + n + q) * 2], ci = CC[((d * 16 + co) * 64 + n + q) * 2 + 1];
                        vv[q] = reim ? -(cr * pi + ci * pr) : (cr * pr - ci * pi); }
                    *(unsigned*)(Tm + ((size_t)g * 512 + row) * UGK + 512 + kk) = pk2(vv[0], vv[1]); }
            } else {
                const int d = part - 6;
                for (int i = tid; i < 1056; i += NTHR) *(LAS f32x4*)(PW + d * 4224 + i * 4) = *(const f32x4*)(PWG + ((size_t)g * 2 + d) * 4224 + (size_t)i * 4);
                *(LAS f32x4*)(BB + d * 2048 + tid * 4) = *(const f32x4*)(BBG + ((size_t)g * 2 + d) * 2048 + (size_t)tid * 4);
                __syncthreads();
                for (int idx = tid; idx < 128 * 256; idx += NTHR) { const int rl = idx >> 8, kp = idx & 255; const int reim = rl >> 6, n = rl & 63, k = 2 * kp, t = k >> 4, ci = k & 15; const int j = d ? t : 31 - t;
                    const float pr = PW[((d * 33 + j) * 64 + n) * 2], pi = PW[((d * 33 + j) * 64 + n) * 2 + 1]; float vv[2];
#pragma unroll
                    for (int q = 0; q < 2; ++q) { const float br = BB[((d * 64 + n) * 16 + ci + q) * 2], bi = BB[((d * 64 + n) * 16 + ci + q) * 2 + 1]; vv[q] = reim ? (pr * bi + pi * br) : (pr * br - pi * bi); }
                    *(unsigned*)(Pm + ((size_t)g * 256 + d * 128 + rl) * 512 + k) = pk2(vv[0], vv[1]); }
            }
            __syncthreads();
        }
        for (int i = bx * NTHR + tid; i < 5 * 6144; i += G * NTHR) MODF[i] = (float)((double)__hip_atomic_load(modacc + i, __ATOMIC_RELAXED, __HIP_MEMORY_SCOPE_AGENT) * (1.0 / (double)FX_ONE)) + args.in[5][i % 6144];
        LAS float* shs = (LAS float*)lds;
        const int bat = bx / (G / 4);
        for (int i = tid; i < 4096; i += NTHR) { const int which = i >> 11, c = i & 2047; const int mv = which ? 4 : bat;
            shs[i] = (float)((double)__hip_atomic_load(modacc + mv * 6144 + c, __ATOMIC_RELAXED, __HIP_MEMORY_SCOPE_AGENT) * (1.0 / (double)FX_ONE)) + args.in[5][c]; }
        __syncthreads();
        const int rows_per_blk = T / G;
        for (int it = 0; it < rows_per_blk / (2 * NWAVES); ++it) {
            f32x4 v[2][4], pe[2][4];
#pragma unroll
            for (int h = 0; h < 2; ++h) { const int r = bx * rows_per_blk + wave + 16 * it + 8 * h; const int l = r & (L - 1); const float* pr = POSR + (l >> 6) * 512; const float* pc = POSC + (l & 63) * 512;
#pragma unroll
                for (int j = 0; j < 4; ++j) { const int d0 = 256 * j + 4 * lane; v[h][j] = ldnt4(args.in[0] + (size_t)r * D + d0); pe[h][j] = (j < 2) ? *(const f32x4*)(pr + d0) : *(const f32x4*)(pc + d0 - 512); } }
            __builtin_amdgcn_sched_barrier(0);
#pragma unroll
            for (int h = 0; h < 2; ++h) { const int r = bx * rows_per_blk + wave + 16 * it + 8 * h; float s = 0.f;
#pragma unroll
                for (int j = 0; j < 4; ++j) { v[h][j] += pe[h][j]; s += (v[h][j][0] + v[h][j][1]) + (v[h][j][2] + v[h][j][3]); }
                const float mean = wsum(s) * (1.f / D); float s2 = 0.f;
#pragma unroll
                for (int j = 0; j < 4; ++j) { v[h][j] = v[h][j] - mean; s2 += (v[h][j][0] * v[h][j][0] + v[h][j][1] * v[h][j][1]) + (v[h][j][2] * v[h][j][2] + v[h][j][3] * v[h][j][3]); }
                const float rstd = rsqrtf(wsum(s2) * (1.f / D) + LN_EPS);
#pragma unroll
                for (int j = 0; j < 4; ++j) { const int d0 = 256 * j + 4 * lane; const f32x4 hh = *(const LAS f32x4*)(shs + d0), cc = *(const LAS f32x4*)(shs + 1024 + d0);
                    const f32x4 o = v[h][j] * rstd * (cc + 1.0f) + hh; u32x2 w; w.x = cvt_pk_bf16(o[0], o[1]); w.y = cvt_pk_bf16(o[2], o[3]);
                    *(u32x2*)(XN + (size_t)r * D + d0) = w; } }
        }
        for (int task = bx; task < 256; task += G) {
            const int c0 = 16 * (task >> 2), nn0 = 128 * (task & 3) + 16 * wave; const LAS float* sh = shs + 2048;
#pragma unroll 1
            for (int rr = 0; rr < 2; ++rr) { const int r = T + c0 + 2 * wave + rr; const float* src = args.in[2] + (size_t)(r - T) * D;
                f32x4 v[4]; float s = 0.f;
#pragma unroll
                for (int j = 0; j < 4; ++j) { v[j] = *(const f32x4*)(src + 256 * j + 4 * lane); }
#pragma unroll
                for (int j = 0; j < 4; ++j) s += (v[j][0] + v[j][1]) + (v[j][2] + v[j][3]);
                const float mean = wsum(s) * (1.f / D); float s2 = 0.f;
#pragma unroll
                for (int j = 0; j < 4; ++j) { v[j] = v[j] - mean; s2 += (v[j][0] * v[j][0] + v[j][1] * v[j][1]) + (v[j][2] * v[j][2] + v[j][3] * v[j][3]); }
                const float rstd = rsqrtf(wsum(s2) * (1.f / D) + LN_EPS);
#pragma unroll
                for (int j = 0; j < 4; ++j) { const int d0 = 256 * j + 4 * lane; const f32x4 hh = *(const LAS f32x4*)(sh + d0), cc = *(const LAS f32x4*)(sh + 1024 + d0);
                    const f32x4 o = v[j] * rstd * (cc + 1.0f) + hh; u32x2 w; w.x = cvt_pk_bf16(o[0], o[1]); w.y = cvt_pk_bf16(o[2], o[3]);
                    *(u32x2*)(XN + (size_t)r * D + d0) = w; } }
            asm volatile("s_waitcnt vmcnt(0)" ::: "memory");
            __syncthreads();
            { const int m = lane & 15, q = lane >> 4; const bf16* arow = XN + (size_t)(T + c0 + m) * D + 8 * q; const bf16* brow = Win_t + (size_t)(nn0 + m) * D + 8 * q;
              f32x4 cacc = (f32x4){0.f, 0.f, 0.f, 0.f};
#pragma unroll 1
              for (int cb = 0; cb < 4; ++cb) { bf16x8 af[8], bfv[8];
#pragma unroll
                  for (int c = 0; c < 8; ++c) { af[c] = *(const bf16x8*)(arow + 32 * (8 * cb + c)); bfv[c] = *(const bf16x8*)(brow + 32 * (8 * cb + c)); }
                  __builtin_amdgcn_sched_barrier(0);
#pragma unroll
                  for (int c = 0; c < 8; ++c) cacc = __builtin_amdgcn_mfma_f32_16x16x32_bf16(af[c], bfv[c], cacc, 0, 0, 0); }
#pragma unroll
              for (int i = 0; i < 4; ++i) UG[ug_index(T + c0 + 4 * q + i, nn0 + m)] = f2bf(cacc[i]); }
            __syncthreads();
        }
        }
        if (BOTH(1)) { xcd_barrier(bar); if (DUPBAR) xcd_barrier(bar); }
    }
    if (IN(2)) {
        for (int rep_ = 0; rep_ < ((DUPMASK >> 2) & 1) + 1; ++rep_) {
        EpiInProj E{UG, WC, GB, SA, SB};
        SchedInProj S{(const char*)XN, (const char*)Win_t, G, bx};
        gemm_phase<EpiInProj, SchedInProj, false>(lds, D, D * 2, D * 2, S, E);
        }
        if (BOTH(2)) { xcd_barrier(bar); if (DUPBAR) xcd_barrier(bar); }
    }

    if (IN(3)) {
        for (int rep_ = 0; rep_ < ((DUPMASK >> 3) & 1) + 1; ++rep_) {
        { SchedSend S{(const char*)UG, (const char*)Pm, G, bx}; EpiSend E{SEND};
          gemm_phase<EpiSend, SchedSend, false>(lds, 512, UGK * 2, 1024u, S, E); }
        { const int c0 = (tid & 63) * 8; float cw[3][8];
#pragma unroll
          for (int q = 0; q < 3; ++q)
#pragma unroll
              for (int k = 0; k < 8; ++k) cw[q][k] = args.in[24][q * 512 + c0 + k];
          const int rows_per_blk = T / G;
          for (int rr = tid >> 6; rr < rows_per_blk; rr += NWAVES) { const int r = bx * rows_per_blk + rr; const int p = r & 63; const size_t idx = (size_t)r * 512 + c0;
              const u32x4 z = {0u, 0u, 0u, 0u};
              const u32x4 wm = (p > 0) ? *(const u32x4*)(WC + idx - 512) : z, w0 = *(const u32x4*)(WC + idx), wp = (p < 63) ? *(const u32x4*)(WC + idx + 512) : z, gb = ldnt4u(GB + idx);
              float o[8];
#pragma unroll
              for (int k = 0; k < 4; ++k) { const unsigned a = wm[k], b = w0[k], c = wp[k], g_ = gb[k];
                  o[2 * k] = blo(g_) * (cw[0][2 * k] * blo(a) + cw[1][2 * k] * blo(b) + cw[2][2 * k] * blo(c));
                  o[2 * k + 1] = bhi(g_) * (cw[0][2 * k + 1] * bhi(a) + cw[1][2 * k + 1] * bhi(b) + cw[2][2 * k + 1] * bhi(c)); }
              u32x4 w; w.x = cvt_pk_bf16(o[0], o[1]); w.y = cvt_pk_bf16(o[2], o[3]); w.z = cvt_pk_bf16(o[4], o[5]); w.w = cvt_pk_bf16(o[6], o[7]);
              *(u32x4*)(A2 + idx) = w; } }
        }
        if (BOTH(3)) { xcd_barrier(bar); if (DUPBAR) xcd_barrier(bar); }
    }
    if (IN(4)) {
        for (int rep_ = 0; rep_ < ((DUPMASK >> 4) & 1) + 1; ++rep_) {
        LAS float* seg = (LAS float*)lds;
        for (int item = bx; item < 256; item += G) {
            const int b = item >> 6, d = (item >> 5) & 1, g = item & 31, n = lane; const int pb = d ? 14 : 7;
            const float dt = expf(args.in[pb][g]); const float lnm = dt * args.in[pb + 1][g * NS + n], th = dt * args.in[pb + 2][g * NS + n];
            const float m32 = expf(32.f * lnm); const float ar = m32 * cosf(32.f * th), ai = m32 * sinf(32.f * th);
            const float mS = expf(1056.f * lnm); const float Ar = mS * cosf(1056.f * th), Ai = mS * sinf(1056.f * th);
            float er[33], ei[33];
            const float* sbase = SEND + (size_t)g * NCR * 256 + d * 128 + n;
#pragma unroll
            for (int k = 0; k < 33; ++k) { const int pos = wave * 33 + k; const int crow = (pos < 8) ? 1024 + 8 * b + (d ? 7 - pos : pos) : 256 * b + (d ? 255 - (pos - 8) : (pos - 8));
                er[k] = __builtin_nontemporal_load(sbase + (size_t)crow * 256); ei[k] = __builtin_nontemporal_load(sbase + (size_t)crow * 256 + 64); }
            float sr = 0.f, si = 0.f;
#pragma unroll
            for (int k = 0; k < 33; ++k) { const float nr = ar * sr - ai * si + er[k], ni = ar * si + ai * sr + ei[k]; sr = nr; si = ni; }
            seg[(wave * 64 + n) * 2] = sr; seg[(wave * 64 + n) * 2 + 1] = si;
            __syncthreads();
            sr = 0.f; si = 0.f;
            for (int w = 0; w < wave; ++w) { const float tr = seg[(w * 64 + n) * 2], ti = seg[(w * 64 + n) * 2 + 1]; const float nr = Ar * sr - Ai * si + tr, ni = Ar * si + Ai * sr + ti; sr = nr; si = ni; }
            bf16* ubase = UG + (size_t)g * NCR * UGK + 512 + d * 128 + n;
#pragma unroll
            for (int k = 0; k < 33; ++k) { const int pos = wave * 33 + k;
                if (pos >= 8) { const int crow = 256 * b + (d ? 255 - (pos - 8) : (pos - 8)); ubase[(size_t)crow * UGK] = f2bf(sr); ubase[(size_t)crow * UGK + 64] = f2bf(si); }
                const float nr = ar * sr - ai * si + er[k], ni = ar * si + ai * sr + ei[k]; sr = nr; si = ni; }
            __syncthreads();
        }
        }
        if (BOTH(4)) { xcd_barrier(bar); if (DUPBAR) xcd_barrier(bar); }
    }
    if (IN(5)) {
        for (int rep_ = 0; rep_ < ((DUPMASK >> 5) & 1) + 1; ++rep_) {
        SchedY S{(const char*)UG, (const char*)Tm, G, bx}; EpiY E{YA};
        gemm_phase<EpiY, SchedY, false>(lds, UGK, UGK * 2, UGK * 2, S, E);
        }
        if (BOTH(5)) { xcd_barrier(bar); if (DUPBAR) xcd_barrier(bar); }
    }

    if (IN(6)) {
        for (int rep_ = 0; rep_ < ((DUPMASK >> 6) & 1) + 1; ++rep_) {
        SchedGluPair S{(const char*)YA, (const char*)Wglu_t, G, bx, (SDUP >> 6) & 1}; MEpiGlu E{TMP, SA};
        gemm_phase<MEpiGlu, SchedGluPair, false>(lds, 512, 1024u, 1024u, S, E);
        }
        if (BOTH(6)) { __builtin_amdgcn_fence(__ATOMIC_ACQUIRE, "agent"); asm volatile("s_waitcnt vmcnt(0)" ::: "memory"); __syncthreads(); }
    }
    if (IN(7)) {
        for (int rep_ = 0; rep_ < ((DUPMASK >> 7) & 1) + 1; ++rep_) {
        SchedGrid S{(const char*)A2, (const char*)Wcv_t, G, bx, 128, 4, 1024u, 1024u, (SDUP >> 7) & 1}; MEpiCv E{MG, TMP, SB};
        gemm_phase<MEpiCv, SchedGrid, false>(lds, 512, 1024u, 1024u, S, E);
        }
        if (BOTH(7)) { xcd_barrier(bar); if (DUPBAR) xcd_barrier(bar); }
    }
    if (IN(8)) {
        for (int rep_ = 0; rep_ < ((DUPMASK >> 8) & 1) + 1; ++rep_) {
        SchedGrid S{(const char*)MG, (const char*)Wo_t, G, bx, 128, 4, 2048u, 2048u, (SDUP >> 8) & 1}; MEpiWo E{MIXG, MODF};
        gemm_phase<MEpiWo, SchedGrid, false>(lds, D, 2048u, 2048u, S, E);
        }
        if (BOTH(8)) { xcd_barrier(bar); if (DUPBAR) xcd_barrier(bar); }
    }
    if (IN(9)) {
        for (int rep_ = 0; rep_ < ((DUPMASK >> 9) & 1) + 1; ++rep_) {
        LAS float* pl = (LAS float*)lds;
        const int bat = bx / (G / 4);
        for (int i = tid; i < 4096; i += NTHR) { const int w = i >> 10, c = i & 1023; pl[i] = (w == 0) ? args.in[27][c] : (w == 1) ? args.in[28][c] : (w == 2) ? MODF[bat * 6144 + 3072 + c] : MODF[bat * 6144 + 4096 + c]; }
        LAS unsigned* wrl = (LAS unsigned*)(lds + 16384);
        LAS float* sl = (LAS float*)(lds + 16384 + 74304);
        LAS int* el = (LAS int*)(lds + 16384 + 74304 + 18944);
        for (int i = tid; i < 4608; i += NTHR) { const int n = i >> 7, c = i & 127; *(LAS u32x4*)(wrl + n * 516 + c * 4) = *(const u32x4*)((const unsigned*)Wr_t + i * 4); }
        __syncthreads();
        const int rows_per_blk = T / G;
        for (int it = 0; it < rows_per_blk / (2 * NWAVES); ++it) {
            f32x4 v[2][4], pe[2][4]; u32x2 mx[2][4];
#pragma unroll
            for (int h = 0; h < 2; ++h) { const int r = bx * rows_per_blk + wave + 16 * it + 8 * h; const int l = r & (L - 1); const float* pr = POSR + (l >> 6) * 512; const float* pc = POSC + (l & 63) * 512;
#pragma unroll
                for (int j = 0; j < 4; ++j) { const int d0 = 256 * j + 4 * lane; v[h][j] = ldnt4(args.in[0] + (size_t)r * D + d0); mx[h][j] = ldnt2u(MIXG + (size_t)r * D + d0);
                    pe[h][j] = (j < 2) ? *(const f32x4*)(pr + d0) : *(const f32x4*)(pc + d0 - 512); } }
            __builtin_amdgcn_sched_barrier(0);
#pragma unroll
            for (int h = 0; h < 2; ++h) { const int r = bx * rows_per_blk + wave + 16 * it + 8 * h; float s = 0.f;
#pragma unroll
                for (int j = 0; j < 4; ++j) { f32x4 mo; mo[0] = blo(mx[h][j].x); mo[1] = bhi(mx[h][j].x); mo[2] = blo(mx[h][j].y); mo[3] = bhi(mx[h][j].y);
                    v[h][j] = (v[h][j] + pe[h][j]) * ALPHA + mo; s += (v[h][j][0] + v[h][j][1]) + (v[h][j][2] + v[h][j][3]); }
                float mean = wsum(s) * (1.f / D), s2 = 0.f;
#pragma unroll
                for (int j = 0; j < 4; ++j) { v[h][j] = v[h][j] - mean; s2 += (v[h][j][0] * v[h][j][0] + v[h][j][1] * v[h][j][1]) + (v[h][j][2] * v[h][j][2] + v[h][j][3] * v[h][j][3]); }
                float rstd = rsqrtf(wsum(s2) * (1.f / D) + LN_EPS); s = 0.f;
#pragma unroll
                for (int j = 0; j < 4; ++j) { const int d0 = 256 * j + 4 * lane; v[h][j] = v[h][j] * rstd * *(const LAS f32x4*)(pl + d0) + *(const LAS f32x4*)(pl + 1024 + d0);
                    u32x2 w; w.x = cvt_pk_bf16(v[h][j][0], v[h][j][1]); w.y = cvt_pk_bf16(v[h][j][2], v[h][j][3]); __builtin_nontemporal_store(w, (u32x2*)(X1B + (size_t)r * D + d0));
                    s += (v[h][j][0] + v[h][j][1]) + (v[h][j][2] + v[h][j][3]); }
                mean = wsum(s) * (1.f / D); s2 = 0.f;
#pragma unroll
                for (int j = 0; j < 4; ++j) { v[h][j] = v[h][j] - mean; s2 += (v[h][j][0] * v[h][j][0] + v[h][j][1] * v[h][j][1]) + (v[h][j][2] * v[h][j][2] + v[h][j][3] * v[h][j][3]); }
                rstd = rsqrtf(wsum(s2) * (1.f / D) + LN_EPS);
#pragma unroll
                for (int j = 0; j < 4; ++j) { const int d0 = 256 * j + 4 * lane; const f32x4 o = v[h][j] * rstd * (*(const LAS f32x4*)(pl + 3072 + d0) + 1.0f) + *(const LAS f32x4*)(pl + 2048 + d0);
                    u32x2 w; w.x = cvt_pk_bf16(o[0], o[1]); w.y = cvt_pk_bf16(o[2], o[3]); *(u32x2*)(H2 + (size_t)r * D + d0) = w; } }
        }
        asm volatile("s_waitcnt vmcnt(0)" ::: "memory");
        __syncthreads();
        {
            const int m = lane & 15, q = lane >> 4; const bf16* arow = H2 + (size_t)(bx * rows_per_blk + 16 * wave + m) * D + 8 * q;
            f32x4 lacc[3];
#pragma unroll
            for (int t = 0; t < 3; ++t) lacc[t] = (f32x4){0.f, 0.f, 0.f, 0.f};
            const LAS unsigned* brow[3];
#pragma unroll
            for (int t = 0; t < 3; ++t) { const int n = 16 * t + m; brow[t] = wrl + (n < 36 ? n : 35) * 516 + 4 * q; }
#pragma unroll 4
            for (int c = 0; c < 32; ++c) { const bf16x8 af = *(const bf16x8*)(arow + 32 * c);
#pragma unroll
                for (int t = 0; t < 3; ++t) { const bf16x8 bf = *(const LAS bf16x8*)(brow[t] + 16 * c); lacc[t] = __builtin_amdgcn_mfma_f32_16x16x32_bf16(af, bf, lacc[t], 0, 0, 0); } }
#pragma unroll
            for (int t = 0; t < 3; ++t) { const int n = 16 * t + m; if (n < 36) { const float bsv = (n < 4) ? args.in[30][n] : args.in[32][n - 4];
#pragma unroll
                for (int i = 0; i < 4; ++i) sl[(16 * wave + 4 * q + i) * 37 + n] = lacc[t][i] + bsv; } }
        }
        __syncthreads();
        {
            const int tpb = T / G;
            if (tid < tpb) { const LAS float* gl = sl + tid * 37; const int t = bx * tpb + tid;
                int gi = 0; float gm = gl[0];
                for (int j = 1; j < 4; ++j) { if (gl[j] > gm) { gm = gl[j]; gi = j; } }
                float gs = 0.f; for (int j = 0; j < 4; ++j) gs += __expf(gl[j] - gm);
                const float pg = 1.f / gs; const LAS float* ee = gl + 4 + gi * 8;
                int i1 = 0; for (int j = 1; j < 8; ++j) if (ee[j] > ee[i1]) i1 = j;
                int i2 = (i1 == 0) ? 1 : 0; for (int j = 0; j < 8; ++j) if (j != i1 && ee[j] > ee[i2]) i2 = j;
                const float e2 = __expf(ee[i2] - ee[i1]); const float w1 = pg / (1.f + e2), w2 = pg * e2 / (1.f + e2);
                eidx[2 * t] = gi * 8 + i1; eidx[2 * t + 1] = gi * 8 + i2; wgt[2 * t] = w1; wgt[2 * t + 1] = w2;
                el[2 * tid] = gi * 8 + i1; el[2 * tid + 1] = gi * 8 + i2; }
            __syncthreads();
            if (tid < 2 * tpb) { const int e = el[tid]; int rk = 0; for (int a_ = 0; a_ < tid; ++a_) rk += (el[a_] == e) ? 1 : 0; rankl[bx * 2 * tpb + tid] = rk; }
            if (tid >= 2 * tpb && tid < 2 * tpb + 32) { const int e = tid - 2 * tpb; int cn = 0; for (int a_ = 0; a_ < 2 * tpb; ++a_) cn += (el[a_] == e) ? 1 : 0; hist[bx * 32 + e] = cn; }
        }
        __syncthreads();
        }
        if (BOTH(9)) { xcd_barrier(bar); if (DUPBAR) xcd_barrier(bar); }
    }
    if (IN(12)) {
        for (int rep_ = 0; rep_ < ((DUPMASK >> 12) & 1) + 1; ++rep_) {
        LAS int* tot = (LAS int*)lds; LAS int* pre = tot + 32; LAS int* off = tot + 64;
        const int tpb = T / G;
        if (tid < 32) { int tt = 0, pp = 0; for (int b = 0; b < G; ++b) { const int h = hist[b * 32 + tid]; tt += h; pp += (b < bx) ? h : 0; } tot[tid] = tt; pre[tid] = pp; }
        __syncthreads();
        if (tid == 0) { int o = 0; for (int e = 0; e < 32; ++e) { off[e] = o; o += (tot[e] + 255) & ~255; } off[32] = o; }
        __syncthreads();
        if (tid < 2 * tpb) { const int a = bx * 2 * tpb + tid; const int e = eidx[a]; const int slot = off[e] + pre[e] + rankl[a]; tokl[slot] = a >> 1; asgl[slot] = a; wsl[slot] = wgt[a]; }
        if (bx < 32) { const int e = bx; const int lo_ = off[e] + tot[e], hi_ = off[e + 1]; for (int sl_ = lo_ + tid; sl_ < hi_; sl_ += NTHR) { tokl[sl_] = 0; asgl[sl_] = -1; wsl[sl_] = 0.f; } }
        if (bx == 0 && tid < 33) meta[tid] = off[tid];
        __syncthreads();
        }
        if (BOTH(12)) { xcd_barrier(bar); if (DUPBAR) xcd_barrier(bar); }
    }
    if (IN(13)) {
        for (int rep_ = 0; rep_ < ((DUPMASK >> 13) & 1) + 1; ++rep_) {
        SchedExp S{(const char*)H2, (const char*)Wgu_t, tokl, meta, G, bx, 2048u, 2048u, (size_t)D * D * 2, 1, (SDUP >> 13) & 1}; MEpiHid E{HID};
        gemm_phase<MEpiHid, SchedExp, true>(lds, D, 2048u, 2048u, S, E);
        }
        if (BOTH(13)) { xcd_barrier(bar); if (DUPBAR) xcd_barrier(bar); }
    }
    if (IN(14)) {
        for (int rep_ = 0; rep_ < ((DUPMASK >> 14) & 1) + 1; ++rep_) {
        SchedExp S{(const char*)HID, (const char*)Wd_t, tokl, meta, G, bx, 1024u, 1024u, (size_t)D * FF * 2, 0, (SDUP >> 14) & 1}; MEpiDown E{Y2, asgl, wsl};
        gemm_phase<MEpiDown, SchedExp, false>(lds, FF, 1024u, 1024u, S, E);
        }
        if (BOTH(14)) { xcd_barrier(bar); if (DUPBAR) xcd_barrier(bar); }
    }
    if (IN(15)) {
        LAS float* pl = (LAS float*)lds;
        const int bat = bx / (G / 4);
        for (int i = tid; i < 3072; i += NTHR) { const int w = i >> 10, c = i & 1023; pl[i] = (w == 0) ? args.in[36][c] : (w == 1) ? args.in[37][c] : MODF[bat * 6144 + 5120 + c]; }
        __syncthreads();
        const int rows_per_blk = T / G;
        for (int it = 0; it < rows_per_blk / (2 * NWAVES); ++it) {
            u32x2 xb[2][4], y0[2][4], y1[2][4];
#pragma unroll
            for (int h = 0; h < 2; ++h) { const int r = bx * rows_per_blk + wave + 16 * it + 8 * h;
#pragma unroll
                for (int j = 0; j < 4; ++j) { const int d0 = 256 * j + 4 * lane; xb[h][j] = ldnt2u(X1B + (size_t)r * D + d0);
                    y0[h][j] = ldnt2u(Y2 + (size_t)(2 * r) * D + d0); y1[h][j] = ldnt2u(Y2 + (size_t)(2 * r + 1) * D + d0); } }
            __builtin_amdgcn_sched_barrier(0);
#pragma unroll
            for (int h = 0; h < 2; ++h) { const int r = bx * rows_per_blk + wave + 16 * it + 8 * h; float* orow = args.out + (size_t)r * D; f32x4 v[4]; float s = 0.f;
#pragma unroll
                for (int j = 0; j < 4; ++j) { const int d0 = 256 * j + 4 * lane; const f32x4 g2 = *(const LAS f32x4*)(pl + 2048 + d0);
                    f32x4 x1, mo; x1[0] = blo(xb[h][j].x); x1[1] = bhi(xb[h][j].x); x1[2] = blo(xb[h][j].y); x1[3] = bhi(xb[h][j].y);
                    mo[0] = blo(y0[h][j].x) + blo(y1[h][j].x); mo[1] = bhi(y0[h][j].x) + bhi(y1[h][j].x); mo[2] = blo(y0[h][j].y) + blo(y1[h][j].y); mo[3] = bhi(y0[h][j].y) + bhi(y1[h][j].y);
                    v[j] = x1 * ALPHA + g2 * mo; s += (v[j][0] + v[j][1]) + (v[j][2] + v[j][3]); }
                const float mean = wsum(s) * (1.f / D); float s2 = 0.f;
#pragma unroll
                for (int j = 0; j < 4; ++j) { v[j] = v[j] - mean; s2 += (v[j][0] * v[j][0] + v[j][1] * v[j][1]) + (v[j][2] * v[j][2] + v[j][3] * v[j][3]); }
                const float rstd = rsqrtf(wsum(s2) * (1.f / D) + LN_EPS);
#pragma unroll
                for (int j = 0; j < 4; ++j) { const int d0 = 256 * j + 4 * lane; __builtin_nontemporal_store(v[j] * rstd * *(const LAS f32x4*)(pl + d0) + *(const LAS f32x4*)(pl + 1024 + d0), (f32x4*)(orow + d0)); } }
        }
    }
#undef IN
#undef BOTH
}
}

extern "C" void kernel_launch(void* const* d_in, const int* in_sizes, int n_in, void* d_out, int out_size, void* d_ws, size_t ws_size, hipStream_t stream) {
    if (ws_size < WS_END + 64 * MiB) { fprintf(stderr, "workspace too small: %zu < %zu\n", ws_size, (size_t)WS_END); return; }
    auto F = [&](int i) { return (const float*)d_in[i]; };
    char* ws = (char*)d_ws; float* out = (float*)d_out;
    float* mod = (float*)(ws + WS_MOD);
    char* rt = ws + WS_ROUT; int* eidx = (int*)(rt + RT_EIDX); float* wgt = (float*)(rt + RT_WGT); int* tok = (int*)(rt + RT_TOK); int* asg = (int*)(rt + RT_ASG); int* cnt = (int*)(rt + RT_CNT);
    bf16* XN = (bf16*)(ws + WS_RA); float* YF = (float*)(ws + WS_RA); bf16* TMP = (bf16*)(ws + WS_RA); bf16* H2 = (bf16*)(ws + WS_RA);
    bf16* UG = (bf16*)(ws + WS_RB); bf16* MG = (bf16*)(ws + WS_RB); bf16* HID = (bf16*)(ws + WS_RB);
    bf16* WC = (bf16*)(ws + WS_RD); bf16* YA = WC; bf16* GB = (bf16*)(ws + WS_RD + 32 * MiB); bf16* A2 = (bf16*)(ws + WS_RD + 64 * MiB); bf16* Y2 = (bf16*)(ws + WS_RD);
    bf16* SA = (bf16*)d_out; bf16* SB = SA + (size_t)T * D;
    const float* w_in = F(6);

    static int grid = 0;
    if (grid == 0) {
        int dev = 0, cus = 0, per_cu = 0;
        if (hipGetDevice(&dev) != hipSuccess || hipDeviceGetAttribute(&cus, hipDeviceAttributeMultiprocessorCount, dev) != hipSuccess) { fprintf(stderr, "device query failed\n"); grid = -1; return; }
        if (hipOccupancyMaxActiveBlocksPerMultiprocessor(&per_cu, (const void*)fwd, NTHR, 0) != hipSuccess || per_cu < 1) fprintf(stderr, "occupancy query says %d\n", per_cu);
        (void)hipGetLastError();
        grid = cus;
        if (grid != 256) fprintf(stderr, "warning: grid %d != 256\n", grid);
    }
    if (grid < 0) return;
    (void)hipMemsetAsync(ws + WS_CTL, 0, 1 * MiB, stream);
    Args a{};
    for (int i = 0; i < 38; ++i) a.in[i] = (const float*)d_in[i];
    a.out = out; a.ws = (unsigned char*)d_ws; a.pad = 0;
    auto run = [&](int lo, int hi, int li) { a.ph_lo = lo; a.ph_hi = hi; a.li = li; hipLaunchKernelGGL(fwd, dim3(grid), dim3(NTHR), 0, stream, a); };
#ifndef USE_P1
#define USE_P1 0
#endif
#ifndef USE_P2
#define USE_P2 0
#endif
    run(0, 16, 0);
}
```
